# Optimizing an MI355X kernel written in HIP

```python
import math
import jax, jax.numpy as jnp
from jax import lax
import numpy as np

D_MODEL = 1024
BATCH = 32
SEQ = 256
DEPTH = 2
DEC_BATCH = 2
DEC_SEQ = 1024
PAST_LEN = 256

GRID_W = 64
ROPE_THETA = 10000.0
EPS = 1e-6
NEG_INF = -1e30
Q_BLOCK = 128
CONV_CH = D_MODEL // 2
CONV_WIDTH = 31
DIFF_HEADS = 4
DIFF_SUB_DIM = 64
DIFF_V_DIM = 2 * DIFF_SUB_DIM
DIFF_WIDTH = DIFF_HEADS * DIFF_V_DIM
HEAD_DIM = 64
GQA_HEADS = D_MODEL // HEAD_DIM
GQA_KV_HEADS = 4
GQA_GROUP = GQA_HEADS // GQA_KV_HEADS
WINDOW = 128
FFN_HIDDEN = -(-8 * D_MODEL // (3 * 256)) * 256
N_MOD = 6

kernel_name = 'hybrid_diffusion_prefix_step'


def rms_norm(x, g):
    xf = x.astype(jnp.float32)
    y = xf * lax.rsqrt(jnp.mean(xf * xf, axis=-1, keepdims=True) + EPS)
    return (y * g.astype(jnp.float32)).astype(x.dtype)


def layer_norm(x, g, b):
    xf = x.astype(jnp.float32)
    mu = jnp.mean(xf, axis=-1, keepdims=True)
    xc = xf - mu
    y = xc * lax.rsqrt(jnp.mean(xc * xc, axis=-1, keepdims=True) + EPS)
    return (y * g.astype(jnp.float32) + b.astype(jnp.float32)).astype(x.dtype)


def rope_1d(x, pos):
    d = x.shape[-1]
    inv = 1.0 / (ROPE_THETA ** (jnp.arange(0, d, 2, dtype=jnp.float32) / d))
    ang = pos.astype(jnp.float32)[:, None] * inv[None, :]
    cos = jnp.cos(ang)[None, :, None, :]
    sin = jnp.sin(ang)[None, :, None, :]
    xf = x.astype(jnp.float32)
    x1, x2 = xf[..., : d // 2], xf[..., d // 2:]
    return jnp.concatenate([x1 * cos - x2 * sin, x2 * cos + x1 * sin], axis=-1).astype(x.dtype)


def axial_rope(x):
    shp = x.shape
    B, S, D = shp[0], shp[1], shp[-1]
    xr = x.reshape(B, S, -1, D)
    t = jnp.arange(S)
    rows, cols = t // GRID_W, t % GRID_W
    half = D // 2
    out = jnp.concatenate([rope_1d(xr[..., :half], rows), rope_1d(xr[..., half:], cols)], axis=-1)
    return out.reshape(shp)


def blocked_queries(fn, q):
    B, S = q.shape[:2]
    nb = S // Q_BLOCK
    qb = jnp.moveaxis(q.reshape((B, nb, Q_BLOCK) + q.shape[2:]), 1, 0)
    o = lax.map(fn, qb)
    return jnp.moveaxis(o, 0, 1).reshape((B, S) + o.shape[3:])


def conformer_conv(u, conv_w, conv_b, ln_g, ln_b):
    a, gt = jnp.split(u, 2, axis=-1)
    z = a * jax.nn.sigmoid(gt)
    z = lax.conv_general_dilated(
        z, conv_w.astype(z.dtype), window_strides=(1,),
        padding=[(CONV_WIDTH // 2, CONV_WIDTH // 2)],
        dimension_numbers=('NWC', 'WIO', 'NWC'),
        feature_group_count=CONV_CH) + conv_b
    return jax.nn.silu(layer_norm(z, ln_g, ln_b))


def diff_attention(q, k, v, lam):
    scale = DIFF_SUB_DIM ** -0.5
    def one(qb):
        s = jnp.einsum('bqhjd,bkhjd->bhjqk', qb, k).astype(jnp.float32) * scale
        p = jax.nn.softmax(s, axis=-1)
        w = p[:, :, 0] - lam * p[:, :, 1]
        return jnp.einsum('bhqk,bkhe->bqhe', w.astype(v.dtype), v)
    return blocked_queries(one, q)


def sink_attention(qb, k, v, sink, mask):
    s = jnp.einsum('bqhgd,bkhd->bhgqk', qb, k).astype(jnp.float32) * (HEAD_DIM ** -0.5)
    if mask is not None:
        s = jnp.where(mask, s, NEG_INF)
    sk = jnp.broadcast_to(sink.astype(jnp.float32)[None, :, :, None, None], s.shape[:-1] + (1,))
    p = jax.nn.softmax(jnp.concatenate([s, sk], axis=-1), axis=-1)[..., :-1]
    return jnp.einsum('bhgqk,bkhd->bqhgd', p.astype(v.dtype), v)


def windowed_sink_attention(q, k, v, k_ctx, v_ctx, sink):
    B, S = q.shape[:2]
    nb = S // Q_BLOCK
    span = Q_BLOCK + 2 * WINDOW
    pad = ((0, 0), (WINDOW, WINDOW), (0, 0), (0, 0))
    kp, vp = jnp.pad(k, pad), jnp.pad(v, pad)
    i = jnp.arange(Q_BLOCK)[:, None]
    j = jnp.arange(span)[None, :]
    band = jnp.abs(i - j + WINDOW) <= WINDOW
    ctx_valid = jnp.ones((Q_BLOCK, k_ctx.shape[1]), dtype=bool)
    def one(b):
        start = b * Q_BLOCK
        qb = lax.dynamic_slice_in_dim(q, start, Q_BLOCK, axis=1)
        kw = lax.dynamic_slice_in_dim(kp, start, span, axis=1)
        vw = lax.dynamic_slice_in_dim(vp, start, span, axis=1)
        kpos = start - WINDOW + j
        valid = band & (kpos >= 0) & (kpos < S)
        keys = jnp.concatenate([kw, k_ctx], axis=1)
        vals = jnp.concatenate([vw, v_ctx], axis=1)
        mask = jnp.concatenate([valid, ctx_valid], axis=1)
        return sink_attention(qb, keys, vals, sink, mask)
    o = lax.map(one, jnp.arange(nb))
    return jnp.moveaxis(o, 0, 1).reshape(q.shape)


def mixer_conv_diff(h, p, layer, ctx_kv):
    w_in, conv_w, conv_b, ln_g, ln_b, lam_vec, subln_g, w_out = p
    B, S, _ = h.shape
    proj = h @ w_in
    o0 = 2 * CONV_CH
    u = proj[..., :o0]
    q = proj[..., o0:o0 + DIFF_WIDTH].reshape(B, S, DIFF_HEADS, 2, DIFF_SUB_DIM)
    k = proj[..., o0 + DIFF_WIDTH:o0 + 2 * DIFF_WIDTH].reshape(B, S, DIFF_HEADS, 2, DIFF_SUB_DIM)
    v = proj[..., o0 + 2 * DIFF_WIDTH:].reshape(B, S, DIFF_HEADS, DIFF_V_DIM)
    conv_out = conformer_conv(u, conv_w, conv_b, ln_g, ln_b)
    if ctx_kv is None:
        k_all, v_all, new_kv = k, v, (k, v)
    else:
        q, k = axial_rope(q), axial_rope(k)
        k_all = jnp.concatenate([k, ctx_kv[0]], axis=1)
        v_all = jnp.concatenate([v, ctx_kv[1]], axis=1)
        new_kv = None
    lam_init = 0.8 - 0.6 * math.exp(-0.3 * layer)
    lf = lam_vec.astype(jnp.float32)
    lam = jnp.exp(jnp.sum(lf[0] * lf[1])) - jnp.exp(jnp.sum(lf[2] * lf[3])) + lam_init
    o = diff_attention(q, k_all, v_all, lam)
    o = rms_norm(o, subln_g) * (1.0 - lam_init)
    mixed = jnp.concatenate([conv_out, o.reshape(B, S, DIFF_WIDTH)], axis=-1) @ w_out
    return mixed, new_kv


def mixer_window_gqa(h, p, ctx_kv):
    w_qkv, sink, w_out = p
    B, S, _ = h.shape
    nq, nkv = GQA_HEADS * HEAD_DIM, GQA_KV_HEADS * HEAD_DIM
    proj = h @ w_qkv
    q = proj[..., :nq].reshape(B, S, GQA_KV_HEADS, GQA_GROUP, HEAD_DIM)
    k = proj[..., nq:nq + nkv].reshape(B, S, GQA_KV_HEADS, HEAD_DIM)
    v = proj[..., nq + nkv:].reshape(B, S, GQA_KV_HEADS, HEAD_DIM)
    sink_g = sink.reshape(GQA_KV_HEADS, GQA_GROUP)
    if ctx_kv is None:
        o = blocked_queries(lambda qb: sink_attention(qb, k, v, sink_g, None), q)
        new_kv = (k, v)
    else:
        q, k = axial_rope(q), axial_rope(k)
        o = windowed_sink_attention(q, k, v, ctx_kv[0], ctx_kv[1], sink_g)
        new_kv = None
    return o.reshape(B, S, nq) @ w_out, new_kv


def trunk_layer(x, cond, layer, common, mix, ctx_kv):
    mod_w, mod_b, norm_g, w_gu, w_down = common
    m = jax.nn.silu(cond) @ mod_w + mod_b
    sh1, sc1, g1, sh2, sc2, g2 = jnp.split(m[:, None, :], N_MOD, axis=-1)
    h = rms_norm(x, norm_g[0]) * (1 + sc1) + sh1
    if layer % 2 == 0:
        mixed, kv = mixer_conv_diff(h, mix, layer, ctx_kv)
    else:
        mixed, kv = mixer_window_gqa(h, mix, ctx_kv)
    x = x + g1 * rms_norm(mixed, norm_g[1])
    h = rms_norm(x, norm_g[2]) * (1 + sc2) + sh2
    gate, up = jnp.split(h @ w_gu, 2, axis=-1)
    f = (jax.nn.silu(gate) * up) @ w_down
    x = x + g2 * rms_norm(f, norm_g[3])
    return x, kv


def setup_inputs(seed: int = 0) -> dict:
    key = jax.random.key(seed)
    ks = iter(jax.random.split(key, 40))
    def nrm(shape, scale):
        return jax.random.normal(next(ks), shape, jnp.float32) * scale
    D = D_MODEL
    s = D ** -0.5
    return {
        'x_prompt': nrm((BATCH, SEQ, D), 1.0),
        'x_sample': nrm((DEC_BATCH, DEC_SEQ, D), 1.0),
        'cache_k0': nrm((DEC_BATCH, PAST_LEN, DIFF_HEADS, 2, DIFF_SUB_DIM), 1.0),
        'cache_v0': nrm((DEC_BATCH, PAST_LEN, DIFF_HEADS, DIFF_V_DIM), 1.0),
        'cache_k1': nrm((DEC_BATCH, PAST_LEN, GQA_KV_HEADS, HEAD_DIM), 1.0),
        'cache_v1': nrm((DEC_BATCH, PAST_LEN, GQA_KV_HEADS, HEAD_DIM), 1.0),
        'c': nrm((DEC_BATCH, D), 1.0),
        'c_ctx': nrm((D,), 1.0),
        'l0_mod_w': nrm((D, N_MOD * D), 0.3 * s),
        'l0_mod_b': nrm((N_MOD * D,), 0.02),
        'l0_norm_g': 1.0 + nrm((4, D), 0.02),
        'l0_w_in': nrm((D, 2 * CONV_CH + 3 * DIFF_WIDTH), s),
        'l0_conv_w': nrm((CONV_WIDTH, 1, CONV_CH), CONV_WIDTH ** -0.5),
        'l0_conv_b': nrm((CONV_CH,), 0.02),
        'l0_conv_ln_g': 1.0 + nrm((CONV_CH,), 0.02),
        'l0_conv_ln_b': nrm((CONV_CH,), 0.02),
        'l0_lambda': nrm((4, DIFF_SUB_DIM), 0.1),
        'l0_subln_g': 1.0 + nrm((DIFF_V_DIM,), 0.02),
        'l0_w_out': nrm((CONV_CH + DIFF_WIDTH, D), (CONV_CH + DIFF_WIDTH) ** -0.5),
        'l0_w_gu': nrm((D, 2 * FFN_HIDDEN), s),
        'l0_w_down': nrm((FFN_HIDDEN, D), FFN_HIDDEN ** -0.5),
        'l1_mod_w': nrm((D, N_MOD * D), 0.3 * s),
        'l1_mod_b': nrm((N_MOD * D,), 0.02),
        'l1_norm_g': 1.0 + nrm((4, D), 0.02),
        'l1_w_qkv': nrm((D, (GQA_HEADS + 2 * GQA_KV_HEADS) * HEAD_DIM), s),
        'l1_sink': nrm((GQA_HEADS,), 0.5),
        'l1_w_out': nrm((GQA_HEADS * HEAD_DIM, D), (GQA_HEADS * HEAD_DIM) ** -0.5),
        'l1_w_gu': nrm((D, 2 * FFN_HIDDEN), s),
        'l1_w_down': nrm((FFN_HIDDEN, D), FFN_HIDDEN ** -0.5),
    }


def reference(x_prompt, x_sample, cache_k0, cache_v0, cache_k1, cache_v1, c, c_ctx,
              l0_mod_w, l0_mod_b, l0_norm_g, l0_w_in, l0_conv_w, l0_conv_b, l0_conv_ln_g,
              l0_conv_ln_b, l0_lambda, l0_subln_g, l0_w_out, l0_w_gu, l0_w_down,
              l1_mod_w, l1_mod_b, l1_norm_g, l1_w_qkv, l1_sink, l1_w_out, l1_w_gu, l1_w_down):
    common = ((l0_mod_w, l0_mod_b, l0_norm_g, l0_w_gu, l0_w_down),
              (l1_mod_w, l1_mod_b, l1_norm_g, l1_w_gu, l1_w_down))
    mix = ((l0_w_in, l0_conv_w, l0_conv_b, l0_conv_ln_g, l0_conv_ln_b, l0_lambda, l0_subln_g, l0_w_out),
           (l1_w_qkv, l1_sink, l1_w_out))
    caches = ((cache_k0, cache_v0), (cache_k1, cache_v1))
    ctx_cond = c_ctx[None, :]
    y_prompt = x_prompt
    new_kv = []
    for layer in range(DEPTH):
        y_prompt, kv = trunk_layer(y_prompt, ctx_cond, layer, common[layer], mix[layer], None)
        new_kv.append(kv)
    y_sample = x_sample
    for layer in range(DEPTH):
        y_sample, _ = trunk_layer(y_sample, c, layer, common[layer], mix[layer], caches[layer])
    (new_k0, new_v0), (new_k1, new_v1) = new_kv
    return (y_prompt, y_sample, new_k0, new_v0, new_k1, new_v1)
```

```cpp
#include <hip/hip_runtime.h>
#include <hip/hip_cooperative_groups.h>
#include <cstdio>
#include <cstdint>
namespace cg = cooperative_groups;
namespace pg8 {
#define PG8_LAS __attribute__((address_space(3)))
typedef unsigned short bf16_t;
typedef short bf16x8 __attribute__((ext_vector_type(8)));
typedef float f32x4 __attribute__((ext_vector_type(4)));
typedef unsigned u32x4 __attribute__((ext_vector_type(4)));
constexpr int BM = 256, BK = 64, HALF = 128, HTB = HALF * BK * 2  , STAGE_BYTES = 8 * HTB, NXCD = 8, WGM = 8;

__host__ __device__ __forceinline__ int lds_byte(int r, int c) { const int st = (r >> 4) * 2 + (c >> 5), rr = r & 15, cc = c & 31, ob = rr * 64 + cc * 2; return st * 1024 + (ob ^ (((ob >> 9) & 1) << 5)); }
__host__ __device__ __forceinline__ void stage_rc(int b, int& R, int& C) { const int st = b / 1024, sb = b % 1024, swz = sb ^ (((sb >> 9) & 1) << 5); R = (st >> 1) * 16 + swz / 64; C = (st & 1) * 32 + (swz % 64) / 2; }
__host__ __device__ __forceinline__ int perm32(int rho) { const int n = rho >> 4, i = rho & 15; return 8 * (i >> 2) + 4 * n + (i & 3); }

struct Unit { int pm, pn; };
struct Gemm { const bf16_t* A; const bf16_t* Bt; int M, N, K; };

struct StaticOrder {
    int nM, nN, nwg, G, c;
    __host__ __device__ void init(int M, int N, int G_, int c_) { nM = M / BM; nN = N / BM; nwg = nM * nN; G = G_; c = c_; }
    __host__ __device__ bool next(int i, Unit& u) const {
        const long L = (long)i * G + c; if (L >= nwg) return false;
        int wgid = (int)L; { const int q = nwg / NXCD, r = nwg % NXCD, xcd = wgid % NXCD, off = wgid / NXCD; wgid = (xcd < r ? xcd * (q + 1) : r * (q + 1) + (xcd - r) * q) + off; }
        const int nig = WGM * nN, gid = wgid / nig, fm = gid * WGM, gsz = (nM - fm) < WGM ? (nM - fm) : WGM;
        u.pm = fm + ((wgid % nig) % gsz); u.pn = (wgid % nig) / gsz; return true;
    }
    __device__ __forceinline__ void a_ready(const Unit&) const {}
    __device__ __forceinline__ void done(const Unit&) const {}
};

__device__ __forceinline__ unsigned cvt_pk_bf16(float lo, float hi) { unsigned r; asm volatile("v_cvt_pk_bf16_f32 %0, %1, %2" : "=v"(r) : "v"(lo), "v"(hi)); return r; }
typedef float f32x2 __attribute__((ext_vector_type(2)));
template <class Epi, class Sched, bool ALIGN_EPI = false, bool SP2 = false>
__device__ __forceinline__ void gemm_phase(PG8_LAS unsigned char* lds, const Gemm g, const Sched& S, const Epi& E) {
    const int tid = threadIdx.x, wid = __builtin_amdgcn_readfirstlane(tid >> 6), lane = tid & 63, wr = wid >> 2, wc = wid & 3, fr = lane & 15, fq = lane >> 4;
    const int K = g.K, nt = K / BK;
    unsigned voffA[2], voffB[2];
#pragma unroll
    for (int i = 0; i < 2; ++i) { int R, C; stage_rc(tid * 16 + i * 8192, R, C); const int Rb = Epi::PERM ? ((R & ~31) + perm32(R & 31)) : R;
        voffA[i] = (unsigned)(R * K + C) * 2u; voffB[i] = (unsigned)(Rb * K + C) * 2u; }
    const size_t kstep = (size_t)(BK * 2);
    const size_t hstep = (size_t)HALF * K * 2;
    const size_t tstep = 2 * hstep;
    const unsigned ldsw = (unsigned)wid * 1024u;
    const int aoff = lds_byte(wr * 64 + fr, fq * 8), boff = lds_byte(wc * 32 + fr, fq * 8);
#define PG8_SA(b, h) (((b) * 2 + (h)) * HTB)
#define PG8_SB(b, h) ((4 + (b) * 2 + (h)) * HTB)
#define PG8_STAGE(bufoff, gbase, voff) do { _Pragma("unroll") for (int _i = 0; _i < 2; ++_i) \
        __builtin_amdgcn_global_load_lds((const unsigned*)((const char*)(gbase) + (voff)[_i]), (PG8_LAS unsigned*)(lds + (bufoff) + ldsw + _i * 8192), 16, 0, 0); } while (0)
#define PG8_LDA(dst, b, h) do { _Pragma("unroll") for (int m = 0; m < 4; ++m) _Pragma("unroll") for (int k = 0; k < 2; ++k) dst[m][k] = *(const PG8_LAS bf16x8*)(lds + PG8_SA(b, h) + aoff + m * 2048 + k * 1024); } while (0)
#define PG8_LDB(dst, b, h) do { _Pragma("unroll") for (int n = 0; n < 2; ++n) _Pragma("unroll") for (int k = 0; k < 2; ++k) dst[n][k] = *(const PG8_LAS bf16x8*)(lds + PG8_SB(b, h) + boff + n * 2048 + k * 1024); } while (0)
#define PG8_MMA(ai, bj, At, Bt) do { __builtin_amdgcn_s_setprio(1); _Pragma("unroll") for (int m = 0; m < 4; ++m) _Pragma("unroll") for (int n = 0; n < 2; ++n) _Pragma("unroll") for (int k = 0; k < 2; ++k) \
        acc[ai][bj][m][n] = __builtin_amdgcn_mfma_f32_16x16x32_bf16(Bt[n][k], At[m][k], acc[ai][bj][m][n], 0, 0, 0); __builtin_amdgcn_s_setprio(0); } while (0)
#define PG8_WAIT_V(n) asm volatile("s_waitcnt vmcnt(" #n ")" ::: "memory")
#define PG8_WAIT_L(n) asm volatile("s_waitcnt lgkmcnt(" #n ")" ::: "memory")
#define PG8_BAR __builtin_amdgcn_s_barrier()
#define PG8_SCHED __builtin_amdgcn_sched_barrier(0)
    Unit cur, nxt; int ui = 0;
    if (!S.next(0, cur)) return;
    f32x4 acc[2][2][4][2];
#pragma unroll
    for (int a = 0; a < 2; ++a)
#pragma unroll
        for (int b = 0; b < 2; ++b)
#pragma unroll
            for (int m = 0; m < 4; ++m)
#pragma unroll
                for (int n = 0; n < 2; ++n) acc[a][b][m][n] = (f32x4){0.f, 0.f, 0.f, 0.f};
    bf16x8 At[4][2], B0[2][2], B1[2][2];
    const char* cA = (const char*)g.A + (size_t)cur.pm * tstep; const char* cB = (const char*)g.Bt + (size_t)cur.pn * tstep;
    S.a_ready(cur);
    if constexpr (SP2) {
        PG8_STAGE(PG8_SB(0, 0), cB, voffB); PG8_STAGE(PG8_SB(0, 1), cB + hstep, voffB); PG8_STAGE(PG8_SA(0, 0), cA, voffA); PG8_STAGE(PG8_SA(0, 1), cA + hstep, voffA);
        if (wr == 1) PG8_BAR;
        PG8_WAIT_V(2); PG8_BAR;
        PG8_STAGE(PG8_SB(1, 0), cB + kstep, voffB); PG8_STAGE(PG8_SA(1, 0), cA + kstep, voffA); PG8_STAGE(PG8_SB(1, 1), cB + hstep + kstep, voffB);
        PG8_WAIT_V(6); PG8_BAR;
    } else {
        PG8_STAGE(PG8_SB(0, 0), cB, voffB); PG8_STAGE(PG8_SA(0, 0), cA, voffA); PG8_STAGE(PG8_SB(0, 1), cB + hstep, voffB); PG8_STAGE(PG8_SA(0, 1), cA + hstep, voffA);
        if (wr == 1) PG8_BAR;
        PG8_WAIT_V(4); PG8_BAR;
        PG8_STAGE(PG8_SB(1, 0), cB + kstep, voffB); PG8_STAGE(PG8_SA(1, 0), cA + kstep, voffA); PG8_STAGE(PG8_SB(1, 1), cB + hstep + kstep, voffB);
        PG8_WAIT_V(6); PG8_BAR;
    }
    for (;;) {
        const bool has_next = S.next(ui + 1, nxt);
        const char* nA = has_next ? (const char*)g.A + (size_t)nxt.pm * tstep : cA; const char* nB = has_next ? (const char*)g.Bt + (size_t)nxt.pn * tstep : cB;
        for (int t = 0; t < nt; t += 2) {
            const bool last = (t == nt - 2);
            const char* a1 = cA + (size_t)(t + 1) * kstep;
            const char* a2 = last ? nA : cA + (size_t)(t + 2) * kstep; const char* b2 = last ? nB : cB + (size_t)(t + 2) * kstep;
            const char* a3 = a2 + kstep; const char* b3 = b2 + kstep;
            if (last && has_next) S.a_ready(nxt);
            if constexpr (SP2) {
            PG8_LDB(B0, 0, 0); PG8_LDB(B1, 0, 1); PG8_SCHED; PG8_LDA(At, 0, 0); PG8_STAGE(PG8_SA(1, 1), a1 + hstep, voffA);
            PG8_WAIT_V(8); PG8_WAIT_L(0); PG8_BAR; PG8_MMA(0, 0, At, B0); PG8_MMA(0, 1, At, B1); PG8_BAR; PG8_SCHED;
            PG8_LDA(At, 0, 1); PG8_STAGE(PG8_SB(0, 0), b2, voffB); PG8_STAGE(PG8_SB(0, 1), b2 + hstep, voffB); PG8_STAGE(PG8_SA(0, 0), a2, voffA);
            PG8_WAIT_V(8); PG8_WAIT_L(0); PG8_BAR; PG8_MMA(1, 0, At, B0); PG8_MMA(1, 1, At, B1); PG8_BAR; PG8_SCHED;
            PG8_LDB(B0, 1, 0); PG8_LDB(B1, 1, 1); PG8_SCHED; PG8_LDA(At, 1, 0); PG8_STAGE(PG8_SA(0, 1), a2 + hstep, voffA);
            PG8_WAIT_V(8); PG8_WAIT_L(0); PG8_BAR; PG8_MMA(0, 0, At, B0); PG8_MMA(0, 1, At, B1); PG8_BAR; PG8_SCHED;
            PG8_LDA(At, 1, 1); PG8_STAGE(PG8_SB(1, 0), b3, voffB); PG8_STAGE(PG8_SB(1, 1), b3 + hstep, voffB); PG8_STAGE(PG8_SA(1, 0), a3, voffA);
            PG8_WAIT_V(8); PG8_WAIT_L(0); PG8_BAR; PG8_MMA(1, 0, At, B0); PG8_MMA(1, 1, At, B1); PG8_BAR; PG8_SCHED;
            } else {
            PG8_LDB(B0, 0, 0); PG8_SCHED; PG8_LDA(At, 0, 0); PG8_STAGE(PG8_SA(1, 1), a1 + hstep, voffA);
            PG8_WAIT_L(8); PG8_BAR; PG8_WAIT_L(0); PG8_MMA(0, 0, At, B0); PG8_BAR; PG8_SCHED;
            PG8_LDB(B1, 0, 1); PG8_STAGE(PG8_SB(0, 0), b2, voffB);
            PG8_BAR; PG8_WAIT_L(0); PG8_MMA(0, 1, At, B1); PG8_BAR;
            PG8_LDA(At, 0, 1); PG8_STAGE(PG8_SA(0, 0), a2, voffA);
            PG8_BAR; PG8_WAIT_L(0); PG8_MMA(1, 0, At, B0); PG8_BAR; PG8_SCHED;
            PG8_STAGE(PG8_SB(0, 1), b2 + hstep, voffB);
            PG8_WAIT_V(6); PG8_BAR; PG8_MMA(1, 1, At, B1); PG8_BAR;
            PG8_LDB(B0, 1, 0); PG8_SCHED; PG8_LDA(At, 1, 0); PG8_STAGE(PG8_SA(0, 1), a2 + hstep, voffA);
            PG8_WAIT_L(8); PG8_BAR; PG8_WAIT_L(0); PG8_MMA(0, 0, At, B0); PG8_BAR; PG8_SCHED;
            PG8_LDB(B1, 1, 1); PG8_STAGE(PG8_SB(1, 0), b3, voffB);
            PG8_BAR; PG8_WAIT_L(0); PG8_MMA(0, 1, At, B1); PG8_BAR;
            PG8_LDA(At, 1, 1); PG8_STAGE(PG8_SA(1, 0), a3, voffA);
            PG8_BAR; PG8_WAIT_L(0); PG8_MMA(1, 0, At, B0); PG8_BAR; PG8_SCHED;
            PG8_STAGE(PG8_SB(1, 1), b3 + hstep, voffB);
            PG8_WAIT_V(6); PG8_BAR; PG8_MMA(1, 1, At, B1); PG8_BAR;
            }
        }
        if constexpr (ALIGN_EPI) { if (wr == 0) PG8_BAR; }
        if constexpr (!Epi::AFTER_DRAIN) { E(acc, cur, wr, wc, fr, fq); S.done(cur); }
        if (!has_next) break;
#pragma unroll
        for (int a = 0; a < 2; ++a)
#pragma unroll
            for (int b = 0; b < 2; ++b)
#pragma unroll
                for (int m = 0; m < 4; ++m)
#pragma unroll
                    for (int n = 0; n < 2; ++n) acc[a][b][m][n] = (f32x4){0.f, 0.f, 0.f, 0.f};
        cur = nxt; cA = nA; cB = nB; ++ui;
        if constexpr (ALIGN_EPI) { if (wr == 1) PG8_BAR; }
    }
    PG8_WAIT_V(0);
    if constexpr (!ALIGN_EPI) { if (wr == 0) PG8_BAR; }
    PG8_BAR;
    if constexpr (Epi::AFTER_DRAIN) { E.fused(acc, cur, wr, wc, fr, fq, lds, wid, lane); S.done(cur); }
#undef PG8_SA
#undef PG8_SB
#undef PG8_STAGE
#undef PG8_LDA
#undef PG8_LDB
#undef PG8_MMA
#undef PG8_WAIT_V
#undef PG8_WAIT_L
#undef PG8_BAR
#undef PG8_SCHED
}
}

#ifndef MK_PER_PHASE
#define MK_PER_PHASE 0
#endif
#define GAS __attribute__((address_space(1)))
#define LAS __attribute__((address_space(3)))
typedef unsigned short bf16;
typedef unsigned v4u __attribute__((ext_vector_type(4)));
typedef unsigned v2u __attribute__((ext_vector_type(2)));
using pg8::f32x4; using pg8::bf16x8; using pg8::Unit; using pg8::cvt_pk_bf16;

constexpr int D = 1024, MP = 8192, MS = 2048, MT = 10240;
constexpr int NIN0 = 2560, NQKV1 = 1536, FH = 2816, NGU = 5632;
constexpr float EPS = 1e-6f, LOG2E = 1.4426950408889634f;
constexpr int NPH = 16;
constexpr size_t O_Y = 0, O_NK0 = 10485760, O_NV0 = 14680064, O_NK1 = 18874368, O_NV1 = 20971520;
constexpr size_t MiB = 1u << 20;
constexpr size_t WS_MOD = 0;
constexpr size_t WS_LAM = 262144;
constexpr size_t WS_ROPEC = 327680, WS_ROPES = 327680 + 4096;
constexpr size_t WS_WIN0 = 1 * MiB, WS_WOUT0 = 6 * MiB, WS_WGU0 = 8 * MiB, WS_WDN0 = 19 * MiB;
constexpr size_t WS_WQKV1 = 25 * MiB, WS_WOUT1 = 28 * MiB, WS_WGU1 = 30 * MiB, WS_WDN1 = 41 * MiB;
constexpr size_t WS_H = 47 * MiB, WS_Z = 67 * MiB, WS_Q0 = 77 * MiB, WS_Q1 = 67 * MiB;
constexpr size_t WS_K0 = 87 * MiB, WS_VT0P = 98 * MiB, WS_VT0S = 106 * MiB;
constexpr size_t WS_CAT = 109 * MiB, WS_MIX = 129 * MiB, WS_ACT = 149 * MiB;
constexpr size_t WS_K1 = 204 * MiB, WS_VT1P = 210 * MiB, WS_VT1S = 214 * MiB, WS_END = 216 * MiB;
constexpr int LDS_BYTES = 147456;

struct Args { const float* in[29]; float* out; unsigned char* ws; int ph_lo, ph_hi; };

__device__ __forceinline__ unsigned f2bf(float f) { unsigned u = __builtin_bit_cast(unsigned, f); return (u + 0x7fffu + ((u >> 16) & 1u)) >> 16; }
__device__ __forceinline__ unsigned pk2(float lo, float hi) { return f2bf(lo) | (f2bf(hi) << 16); }
__device__ __forceinline__ float bflo(unsigned w) { return __builtin_bit_cast(float, w << 16); }
__device__ __forceinline__ float bfhi(unsigned w) { return __builtin_bit_cast(float, w & 0xffff0000u); }
__device__ __forceinline__ v4u pack8(f32x4 a, f32x4 b) { v4u w; w.x = cvt_pk_bf16(a[0], a[1]); w.y = cvt_pk_bf16(a[2], a[3]); w.z = cvt_pk_bf16(b[0], b[1]); w.w = cvt_pk_bf16(b[2], b[3]); return w; }
__device__ __forceinline__ float fsigmoid(float x) { return __builtin_amdgcn_rcpf(1.f + __expf(-x)); }
__device__ __forceinline__ float wave_sum(float v) {
#pragma unroll
    for (int o = 1; o < 64; o <<= 1) v += __shfl_xor(v, o);
    return v;
}

struct EpiStore {
    static constexpr bool PERM = true, AFTER_DRAIN = false;
    bf16* O; int ldc;
    __device__ __forceinline__ void operator()(const f32x4 (&acc)[2][2][4][2], const Unit& u, int wr, int wc, int fr_in, int fq_in) const {
        int fr = fr_in, fq = fq_in; asm volatile("" : "+v"(fr), "+v"(fq));
        const int row0 = u.pm * 256 + wr * 64 + fr, col0 = u.pn * 256 + wc * 32 + 8 * fq;
#pragma unroll
        for (int ai = 0; ai < 2; ++ai)
#pragma unroll
            for (int m = 0; m < 4; ++m) { bf16* rowp = O + (size_t)(row0 + ai * 128 + m * 16) * ldc + col0;
#pragma unroll
                for (int bj = 0; bj < 2; ++bj) *(v4u*)(rowp + bj * 128) = pack8(acc[ai][bj][m][0], acc[ai][bj][m][1]); }
    }
};
struct EpiSwiglu {
    static constexpr bool PERM = true, AFTER_DRAIN = false;
    bf16* O;
    __device__ __forceinline__ void operator()(const f32x4 (&acc)[2][2][4][2], const Unit& u, int wr, int wc, int fr_in, int fq_in) const {
        int fr = fr_in, fq = fq_in; asm volatile("" : "+v"(fr), "+v"(fq));
        const int row0 = u.pm * 256 + wr * 64 + fr, col0 = u.pn * 128 + wc * 32 + 8 * fq;
#pragma unroll
        for (int ai = 0; ai < 2; ++ai)
#pragma unroll
            for (int m = 0; m < 4; ++m) {
                f32x4 r[2];
#pragma unroll
                for (int n = 0; n < 2; ++n)
#pragma unroll
                    for (int e = 0; e < 4; ++e) { const float g = acc[ai][0][m][n][e]; r[n][e] = g * fsigmoid(g) * acc[ai][1][m][n][e]; }
                *(v4u*)(O + (size_t)(row0 + ai * 128 + m * 16) * FH + col0) = pack8(r[0], r[1]); }
    }
};
__device__ __forceinline__ void rope4(f32x4& v, int i0, float sg, const float* rc, const float* rs) {
    const f32x4 c = *(const f32x4*)(rc + i0), s = *(const f32x4*)(rs + i0);
    f32x4 p;
#pragma unroll
    for (int e = 0; e < 4; ++e) p[e] = __shfl_xor(v[e], 32);
    v = v * c + (p * s) * sg;
}
__device__ __forceinline__ void rope8(f32x4& v0, f32x4& v1, int t, int wc, int fq, const float* rc, const float* rs) {
    const int pos = (wc & 1) ? (t & 63) : (t >> 6);
    const int i0 = pos * 16 + 8 * (fq & 1);
    const float sg = (fq & 2) ? 1.f : -1.f;
    rope4(v0, i0, sg, rc, rs); rope4(v1, i0 + 4, sg, rc, rs);
}
struct EpiIn0 {
    static constexpr bool PERM = true, AFTER_DRAIN = false;
    bf16 *Z, *Q0, *K0, *VTP, *VTS; float* out; const float *rc, *rs;
    __device__ __forceinline__ void operator()(const f32x4 (&acc)[2][2][4][2], const Unit& u, int wr, int wc, int fr_in, int fq_in) const {
        int fr = fr_in, fq = fq_in; asm volatile("" : "+v"(fr), "+v"(fq));
        const int pn = u.pn, pm = u.pm; const bool samp = pm >= 32;
        const int sb = (pm - 32) >> 2, tq = ((pm - 32) & 3) * 256;
        if (pn < 4) {
            const int col0 = pn * 128 + wc * 32 + 8 * fq;
#pragma unroll
            for (int ai = 0; ai < 2; ++ai)
#pragma unroll
                for (int m = 0; m < 4; ++m) { const int grow = pm * 256 + ai * 128 + wr * 64 + m * 16 + fr;
                    f32x4 r[2];
#pragma unroll
                    for (int n = 0; n < 2; ++n)
#pragma unroll
                        for (int e = 0; e < 4; ++e) r[n][e] = acc[ai][0][m][n][e] * fsigmoid(acc[ai][1][m][n][e]);
                    *(v4u*)(Z + (size_t)grow * 512 + col0) = pack8(r[0], r[1]); }
        } else if (pn < 8) {
            const bool isk = pn >= 6; const int pp = (pn - 4) & 1;
#pragma unroll
            for (int ai = 0; ai < 2; ++ai)
#pragma unroll
                for (int m = 0; m < 4; ++m) { const int rl = ai * 128 + wr * 64 + m * 16 + fr, grow = pm * 256 + rl, t = tq + rl;
#pragma unroll
                    for (int bj = 0; bj < 2; ++bj) { f32x4 v0 = acc[ai][bj][m][0], v1 = acc[ai][bj][m][1];
                        if (samp) rope8(v0, v1, t, wc, fq, rc, rs);
                        const int col = pp * 256 + bj * 128 + wc * 32 + 8 * fq;
                        if (!isk) { *(v4u*)(Q0 + (size_t)grow * 512 + col) = pack8(v0 * 0.125f, v1 * 0.125f); }
                        else { const int krow = samp ? 8192 + sb * 1280 + t : grow;
                            *(v4u*)(K0 + (size_t)krow * 512 + col) = pack8(v0, v1);
                            if (!samp) { float* o = out + O_NK0 + (size_t)grow * 512 + col; *(f32x4*)o = v0; *(f32x4*)(o + 4) = v1; } } } }
        } else {
            const int pp = pn - 8;
#pragma unroll
            for (int ai = 0; ai < 2; ++ai)
#pragma unroll
                for (int m = 0; m < 4; ++m) { const int rl = ai * 128 + wr * 64 + m * 16 + fr, grow = pm * 256 + rl, t = tq + rl;
#pragma unroll
                    for (int bj = 0; bj < 2; ++bj) { const f32x4 v0 = acc[ai][bj][m][0], v1 = acc[ai][bj][m][1];
                        const int col = pp * 256 + bj * 128 + wc * 32 + 8 * fq, h = pp * 2 + bj, dv0 = wc * 32 + 8 * fq;
                        if (!samp) { float* o = out + O_NV0 + (size_t)grow * 512 + col; *(f32x4*)o = v0; *(f32x4*)(o + 4) = v1; }
                        bf16* vb = samp ? VTS + ((size_t)((sb * 4 + h) * 128 + dv0)) * 1280 + t : VTP + ((size_t)((pm * 4 + h) * 128 + dv0)) * 256 + rl;
                        const int ks = samp ? 1280 : 256;
#pragma unroll
                        for (int e = 0; e < 4; ++e) { vb[(size_t)e * ks] = (bf16)f2bf(v0[e]); vb[(size_t)(e + 4) * ks] = (bf16)f2bf(v1[e]); } } }
        }
    }
};
struct EpiQkv1 {
    static constexpr bool PERM = true, AFTER_DRAIN = false;
    bf16 *Q1, *K1, *VTP, *VTS; float* out; const float *rc, *rs;
    __device__ __forceinline__ void operator()(const f32x4 (&acc)[2][2][4][2], const Unit& u, int wr, int wc, int fr_in, int fq_in) const {
        int fr = fr_in, fq = fq_in; asm volatile("" : "+v"(fr), "+v"(fq));
        const int pn = u.pn, pm = u.pm; const bool samp = pm >= 32;
        const int sb = (pm - 32) >> 2, tq = ((pm - 32) & 3) * 256;
        if (pn < 4) {
#pragma unroll
            for (int ai = 0; ai < 2; ++ai)
#pragma unroll
                for (int m = 0; m < 4; ++m) { const int rl = ai * 128 + wr * 64 + m * 16 + fr, grow = pm * 256 + rl, t = tq + rl;
#pragma unroll
                    for (int bj = 0; bj < 2; ++bj) { f32x4 v0 = acc[ai][bj][m][0], v1 = acc[ai][bj][m][1];
                        if (samp) rope8(v0, v1, t, wc, fq, rc, rs);
                        *(v4u*)(Q1 + (size_t)grow * 1024 + pn * 256 + bj * 128 + wc * 32 + 8 * fq) = pack8(v0 * 0.125f, v1 * 0.125f); } }
        } else if (pn == 4) {
#pragma unroll
            for (int ai = 0; ai < 2; ++ai)
#pragma unroll
                for (int m = 0; m < 4; ++m) { const int rl = ai * 128 + wr * 64 + m * 16 + fr, grow = pm * 256 + rl, t = tq + rl;
#pragma unroll
                    for (int bj = 0; bj < 2; ++bj) { f32x4 v0 = acc[ai][bj][m][0], v1 = acc[ai][bj][m][1];
                        const int cl = bj * 128 + wc * 32 + 8 * fq;
                        if (samp) rope8(v0, v1, t, wc, fq, rc, rs);
                        const int krow = samp ? 8192 + sb * 1280 + t : grow;
                        *(v4u*)(K1 + (size_t)krow * 256 + cl) = pack8(v0, v1);
                        if (!samp) { float* o = out + O_NK1 + (size_t)grow * 256 + cl; *(f32x4*)o = v0; *(f32x4*)(o + 4) = v1; } } }
        } else {
#pragma unroll
            for (int ai = 0; ai < 2; ++ai)
#pragma unroll
                for (int m = 0; m < 4; ++m) { const int rl = ai * 128 + wr * 64 + m * 16 + fr, grow = pm * 256 + rl, t = tq + rl;
#pragma unroll
                    for (int bj = 0; bj < 2; ++bj) { const f32x4 v0 = acc[ai][bj][m][0], v1 = acc[ai][bj][m][1];
                        const int cl = bj * 128 + wc * 32 + 8 * fq, hk = bj * 2 + (wc >> 1), d0 = (wc & 1) * 32 + 8 * fq;
                        if (!samp) { float* o = out + O_NV1 + (size_t)grow * 256 + cl; *(f32x4*)o = v0; *(f32x4*)(o + 4) = v1; }
                        bf16* vb = samp ? VTS + ((size_t)((sb * 4 + hk) * 64 + d0)) * 1280 + t : VTP + ((size_t)((pm * 4 + hk) * 64 + d0)) * 256 + rl;
                        const int ks = samp ? 1280 : 256;
#pragma unroll
                        for (int e = 0; e < 4; ++e) { vb[(size_t)e * ks] = (bf16)f2bf(v0[e]); vb[(size_t)(e + 4) * ks] = (bf16)f2bf(v1[e]); } } }
        }
    }
};

template <int NJ, int DV>
__device__ __forceinline__ void attn_unit(LAS unsigned char* lds, int tid_in, const bf16* Qp, int ldq, const bf16* Kp, int ldk, const bf16* Vt, int ldv,
                                          int a0, int na, int b0, int nb, bool maskB, int qpos0, float lam, const float* subg, float sink, bf16* Op, int ldo) {
    constexpr int KB = NJ * 9216, BUFB = KB + DV * 144, NVC = DV / 64, NDT = DV / 16;
    int tid = tid_in; asm volatile("" : "+v"(tid));
    const int lane = tid & 63, wave = tid >> 6, fr = lane & 15, fq = lane >> 4;
    bf16x8 qf[NJ][2];
#pragma unroll
    for (int j = 0; j < NJ; ++j)
#pragma unroll
        for (int ks = 0; ks < 2; ++ks) qf[j][ks] = *(const bf16x8*)(Qp + (size_t)(wave * 16 + fr) * ldq + j * 64 + ks * 32 + fq * 8);
    f32x4 O[NJ][NDT]; float mrun[NJ], lrun[NJ];
#pragma unroll
    for (int j = 0; j < NJ; ++j) { mrun[j] = -1e30f; lrun[j] = 0.f;
#pragma unroll
        for (int dt = 0; dt < NDT; ++dt) O[j][dt] = (f32x4){0.f, 0.f, 0.f, 0.f}; }
    const int ntiles = na + nb;
    v4u kr[NJ], vr[NVC];
    { const int ks0 = (na > 0) ? a0 : b0;
#pragma unroll
      for (int i = 0; i < NJ; ++i) { const int c = tid + i * 512, key = c / (8 * NJ), part = c % (8 * NJ); kr[i] = *(const v4u*)(Kp + (size_t)(ks0 + key) * ldk + part * 8); }
#pragma unroll
      for (int i = 0; i < NVC; ++i) { const int c = tid + i * 512, dv = c >> 3, kc = c & 7; vr[i] = *(const v4u*)(Vt + (size_t)dv * ldv + ks0 + kc * 8); }
#pragma unroll
      for (int i = 0; i < NJ; ++i) { const int c = tid + i * 512, key = c / (8 * NJ), part = c % (8 * NJ), j = part >> 3, dch = part & 7; *(LAS v4u*)(lds + ((j * 64 + key) * 72 + dch * 8) * 2) = kr[i]; }
#pragma unroll
      for (int i = 0; i < NVC; ++i) { const int c = tid + i * 512, dv = c >> 3, kc = c & 7; *(LAS v4u*)(lds + KB + (dv * 72 + kc * 8) * 2) = vr[i]; }
    }
    __syncthreads();
    for (int it = 0; it < ntiles; ++it) {
        const int kstart = (it < na) ? a0 + 64 * it : b0 + 64 * (it - na);
        const bool more = it + 1 < ntiles;
        if (more) { const int ks1 = (it + 1 < na) ? a0 + 64 * (it + 1) : b0 + 64 * (it + 1 - na);
#pragma unroll
            for (int i = 0; i < NJ; ++i) { const int c = tid + i * 512, key = c / (8 * NJ), part = c % (8 * NJ); kr[i] = *(const v4u*)(Kp + (size_t)(ks1 + key) * ldk + part * 8); }
#pragma unroll
            for (int i = 0; i < NVC; ++i) { const int c = tid + i * 512, dv = c >> 3, kc = c & 7; vr[i] = *(const v4u*)(Vt + (size_t)dv * ldv + ks1 + kc * 8); } }
        const bool masked = maskB && it >= na;
        const int qw = qpos0 + wave * 16;
        const bool skip = masked && (kstart > qw + 15 + 128 || kstart + 63 < qw - 128);
        if (!skip) {
            LAS unsigned char* kb = lds + (it & 1) * BUFB;
            f32x4 s[NJ][4];
#pragma unroll
            for (int j = 0; j < NJ; ++j)
#pragma unroll
                for (int kt = 0; kt < 4; ++kt) { s[j][kt] = (f32x4){0.f, 0.f, 0.f, 0.f};
#pragma unroll
                    for (int ks = 0; ks < 2; ++ks) { const bf16x8 kf = *(const LAS bf16x8*)(kb + ((j * 64 + kt * 16 + fr) * 72 + ks * 32 + fq * 8) * 2);
                        s[j][kt] = __builtin_amdgcn_mfma_f32_16x16x32_bf16(kf, qf[j][ks], s[j][kt], 0, 0, 0); } }
            if (masked) { const int qp = qw + fr;
#pragma unroll
                for (int j = 0; j < NJ; ++j)
#pragma unroll
                    for (int kt = 0; kt < 4; ++kt)
#pragma unroll
                        for (int e = 0; e < 4; ++e) { const int dlt = qp - (kstart + kt * 16 + fq * 4 + e); if (dlt > 128 || dlt < -128) s[j][kt][e] = -1e30f; } }
            bf16x8 pf[NJ][2];
#pragma unroll
            for (int j = 0; j < NJ; ++j) {
                float mx = -1e30f;
#pragma unroll
                for (int kt = 0; kt < 4; ++kt) mx = fmaxf(mx, fmaxf(fmaxf(s[j][kt][0], s[j][kt][1]), fmaxf(s[j][kt][2], s[j][kt][3])));
                mx = fmaxf(mx, __shfl_xor(mx, 16)); mx = fmaxf(mx, __shfl_xor(mx, 32));
                const float mnew = fmaxf(mrun[j], mx), alpha = __builtin_amdgcn_exp2f((mrun[j] - mnew) * LOG2E), mb = mnew * LOG2E;
                mrun[j] = mnew; float ps = 0.f;
#pragma unroll
                for (int kt = 0; kt < 4; ++kt)
#pragma unroll
                    for (int e = 0; e < 4; ++e) { const float p = __builtin_amdgcn_exp2f(s[j][kt][e] * LOG2E - mb); s[j][kt][e] = p; ps += p; }
                lrun[j] = lrun[j] * alpha + ps;
#pragma unroll
                for (int dt = 0; dt < NDT; ++dt) O[j][dt] = O[j][dt] * alpha;
#pragma unroll
                for (int kk = 0; kk < 2; ++kk) { const v4u w = pack8(s[j][2 * kk], s[j][2 * kk + 1]); pf[j][kk] = __builtin_bit_cast(bf16x8, w); }
            }
            LAS unsigned char* vb = kb + KB;
#pragma unroll
            for (int dt = 0; dt < NDT; ++dt)
#pragma unroll
                for (int kk = 0; kk < 2; ++kk) {
                    const v2u lo = *(const LAS v2u*)(vb + ((dt * 16 + fr) * 72 + kk * 32 + fq * 4) * 2), hi = *(const LAS v2u*)(vb + ((dt * 16 + fr) * 72 + kk * 32 + 16 + fq * 4) * 2);
                    const v4u w = {lo.x, lo.y, hi.x, hi.y}; const bf16x8 vf = __builtin_bit_cast(bf16x8, w);
#pragma unroll
                    for (int j = 0; j < NJ; ++j) O[j][dt] = __builtin_amdgcn_mfma_f32_16x16x32_bf16(vf, pf[j][kk], O[j][dt], 0, 0, 0);
                }
        }
        if (more) { LAS unsigned char* nb_ = lds + ((it + 1) & 1) * BUFB;
#pragma unroll
            for (int i = 0; i < NJ; ++i) { const int c = tid + i * 512, key = c / (8 * NJ), part = c % (8 * NJ), j = part >> 3, dch = part & 7; *(LAS v4u*)(nb_ + ((j * 64 + key) * 72 + dch * 8) * 2) = kr[i]; }
#pragma unroll
            for (int i = 0; i < NVC; ++i) { const int c = tid + i * 512, dv = c >> 3, kc = c & 7; *(LAS v4u*)(nb_ + KB + (dv * 72 + kc * 8) * 2) = vr[i]; } }
        __syncthreads();
    }
    float linv[NJ];
#pragma unroll
    for (int j = 0; j < NJ; ++j) { float l = lrun[j]; l += __shfl_xor(l, 16); l += __shfl_xor(l, 32);
        if (NJ == 1) l += __builtin_amdgcn_exp2f((sink - mrun[j]) * LOG2E);
        linv[j] = 1.f / l; }
    bf16* orow = Op + (size_t)(wave * 16 + fr) * ldo + fq * 4;
    if constexpr (NJ == 2) {
        const float i0 = linv[0], i1 = lam * linv[1]; float ss = 0.f;
#pragma unroll
        for (int dt = 0; dt < NDT; ++dt) { O[0][dt] = O[0][dt] * i0 - O[1][dt] * i1;
#pragma unroll
            for (int e = 0; e < 4; ++e) ss += O[0][dt][e] * O[0][dt][e]; }
        ss += __shfl_xor(ss, 16); ss += __shfl_xor(ss, 32);
        const float r = rsqrtf(ss * (1.f / DV) + EPS) * 0.8f;
#pragma unroll
        for (int dt = 0; dt < NDT; ++dt) { const f32x4 g = *(const f32x4*)(subg + dt * 16 + fq * 4); const f32x4 o = O[0][dt] * g * r;
            v2u w; w.x = cvt_pk_bf16(o[0], o[1]); w.y = cvt_pk_bf16(o[2], o[3]); *(v2u*)(orow + dt * 16) = w; }
    } else {
#pragma unroll
        for (int dt = 0; dt < NDT; ++dt) { const f32x4 o = O[0][dt] * linv[0]; v2u w; w.x = cvt_pk_bf16(o[0], o[1]); w.y = cvt_pk_bf16(o[2], o[3]); *(v2u*)(orow + dt * 16) = w; }
    }
}

__device__ __forceinline__ void conv_unit(LAS unsigned char* lds, int tid_in, int unit, const bf16* Z, const float* cw, const float* cb, const float* lg, const float* lb, bf16* CAT) {
    asm volatile("" ::: "memory");
    int tid = tid_in; asm volatile("" : "+v"(tid));
    const int row0 = unit * 32;
    int seq0, slen; if (row0 < MP) { seq0 = row0 & ~255; slen = 256; } else { seq0 = MP + ((row0 - MP) & ~1023); slen = 1024; }
    LAS unsigned char* zt = lds;
    LAS float* co = (LAS float*)(lds + 63488);
#pragma unroll 1
    for (int c = tid; c < 62 * 64; c += 512) { const int r = c >> 6, cc = c & 63, tok = row0 - 15 + r;
        v4u v = {0u, 0u, 0u, 0u}; if (tok >= seq0 && tok < seq0 + slen) v = *(const v4u*)(Z + (size_t)tok * 512 + cc * 8);
        *(LAS v4u*)(zt + r * 1024 + cc * 16) = v; }
    __syncthreads();
    { const int cp = tid & 255, half = tid >> 8;
      float wx[31], wy[31];
#pragma unroll
      for (int w = 0; w < 31; ++w) { const pg8::f32x2 t2 = *(const pg8::f32x2*)(cw + w * 512 + 2 * cp); wx[w] = t2.x; wy[w] = t2.y; }
      const pg8::f32x2 bb = *(const pg8::f32x2*)(cb + 2 * cp);
#pragma unroll 1
      for (int t = 0; t < 16; ++t) { const int tl = half * 16 + t; float ax = bb.x, ay = bb.y;
#pragma unroll
          for (int w = 0; w < 31; ++w) { const unsigned zz = *(const LAS unsigned*)(zt + (tl + w) * 1024 + cp * 4); ax += bflo(zz) * wx[w]; ay += bfhi(zz) * wy[w]; }
          *(LAS pg8::f32x2*)(co + tl * 512 + 2 * cp) = (pg8::f32x2){ax, ay}; } }
    __syncthreads();
    { const int lane = tid & 63, wave = tid >> 6;
      const f32x4 g0 = *(const f32x4*)(lg + lane * 8), g1 = *(const f32x4*)(lg + lane * 8 + 4), b0 = *(const f32x4*)(lb + lane * 8), b1 = *(const f32x4*)(lb + lane * 8 + 4);
#pragma unroll 1
      for (int t = 0; t < 4; ++t) { const int tl = wave * 4 + t;
          f32x4 x0 = *(const LAS f32x4*)(co + tl * 512 + lane * 8), x1 = *(const LAS f32x4*)(co + tl * 512 + lane * 8 + 4);
          const float mu = wave_sum((x0[0] + x0[1]) + (x0[2] + x0[3]) + (x1[0] + x1[1]) + (x1[2] + x1[3])) * (1.f / 512.f);
          x0 = x0 - mu; x1 = x1 - mu;
          const float var = wave_sum((x0[0] * x0[0] + x0[1] * x0[1]) + (x0[2] * x0[2] + x0[3] * x0[3]) + (x1[0] * x1[0] + x1[1] * x1[1]) + (x1[2] * x1[2] + x1[3] * x1[3])) * (1.f / 512.f);
          const float rs = rsqrtf(var + EPS);
          x0 = x0 * rs * g0 + b0; x1 = x1 * rs * g1 + b1;
#pragma unroll
          for (int e = 0; e < 4; ++e) { x0[e] = x0[e] * fsigmoid(x0[e]); x1[e] = x1[e] * fsigmoid(x1[e]); }
          *(v4u*)(CAT + (size_t)(row0 + tl) * 1024 + lane * 8) = pack8(x0, x1); } }
    __syncthreads();
}

__device__ __forceinline__ void rowwise_phase(int gw, int NGW, int lane, const float* xp, const float* xs, const bf16* br, const float* ngA, const float* gate,
                                              float* xout, const float* ngB, const float* mod2, int sc_off, int sh_off, bf16* H) {
    for (int row = gw; row < MT; row += NGW) {
        const int cond = row < MP ? 2 : (row - MP) >> 10;
        const float* xr = row < MP ? xp + (size_t)row * D : xs + (size_t)(row - MP) * D;
        f32x4 x[4];
#pragma unroll
        for (int j = 0; j < 4; ++j) x[j] = *(const f32x4*)(xr + lane * 4 + 256 * j);
        if (br) {
            f32x4 b[4]; float ss = 0.f;
#pragma unroll
            for (int j = 0; j < 4; ++j) { const v2u w = *(const v2u*)(br + (size_t)row * D + lane * 4 + 256 * j); b[j] = (f32x4){bflo(w.x), bfhi(w.x), bflo(w.y), bfhi(w.y)};
                ss += (b[j][0] * b[j][0] + b[j][1] * b[j][1]) + (b[j][2] * b[j][2] + b[j][3] * b[j][3]); }
            const float r = rsqrtf(wave_sum(ss) * (1.f / D) + EPS);
#pragma unroll
            for (int j = 0; j < 4; ++j) { const int col = lane * 4 + 256 * j; const f32x4 g = *(const f32x4*)(gate + cond * 6144 + col), na = *(const f32x4*)(ngA + col);
                x[j] = x[j] + g * (b[j] * r * na); *(f32x4*)(xout + (size_t)row * D + col) = x[j]; }
        }
        if (H) {
            float ss = 0.f;
#pragma unroll
            for (int j = 0; j < 4; ++j) ss += (x[j][0] * x[j][0] + x[j][1] * x[j][1]) + (x[j][2] * x[j][2] + x[j][3] * x[j][3]);
            const float r = rsqrtf(wave_sum(ss) * (1.f / D) + EPS);
#pragma unroll
            for (int j = 0; j < 4; ++j) { const int col = lane * 4 + 256 * j; const f32x4 nb = *(const f32x4*)(ngB + col), sc = *(const f32x4*)(mod2 + cond * 6144 + sc_off + col), sh = *(const f32x4*)(mod2 + cond * 6144 + sh_off + col);
                const f32x4 h = x[j] * r * nb * (sc + 1.f) + sh; v2u w; w.x = cvt_pk_bf16(h[0], h[1]); w.y = cvt_pk_bf16(h[2], h[3]); *(v2u*)(H + (size_t)row * D + col) = w; }
        }
    }
}

__device__ __forceinline__ void p0_transpose_item(const float* W, int K, int N, bf16* WT, int mode, LAS float* scr, int item, int lane) {
    const int nblk = N / 32, kb = item / nblk, nb = item % nblk, k0 = 64 * kb, n0 = 32 * nb;
    int d0 = n0;
    if (mode == 1) { if (n0 < 512) d0 = 256 * (n0 >> 7) + (n0 & 127); else if (n0 < 1024) { const int c = n0 - 512; d0 = 256 * (c >> 7) + 128 + (c & 127); } }
    else if (mode == 2) { if (n0 < FH) d0 = 256 * (n0 >> 7) + (n0 & 127); else { const int c = n0 - FH; d0 = 256 * (c >> 7) + 128 + (c & 127); } }
#pragma unroll 8
    for (int i = 0; i < 32; ++i) { const int kk = 2 * i + (lane >> 5); scr[kk * 33 + (lane & 31)] = W[(size_t)(k0 + kk) * N + n0 + (lane & 31)]; }
    asm volatile("s_waitcnt lgkmcnt(0)" ::: "memory");
    const int c = lane & 7;
#pragma unroll
    for (int j = 0; j < 4; ++j) { const int n = (lane >> 3) + 8 * j; const LAS float* s = scr + (8 * c) * 33 + n;
        v4u o; o.x = pk2(s[0 * 33], s[1 * 33]); o.y = pk2(s[2 * 33], s[3 * 33]); o.z = pk2(s[4 * 33], s[5 * 33]); o.w = pk2(s[6 * 33], s[7 * 33]);
        *(v4u*)(WT + (size_t)(d0 + n) * K + k0 + 8 * c) = o; }
    asm volatile("s_waitcnt lgkmcnt(0)" ::: "memory");
}
__device__ __forceinline__ float fsilu(float x) { return x / (1.f + expf(-x)); }

__device__ __forceinline__ void prep_phase(const Args& a, LAS unsigned char* lds, int gw, int NGW, int wave, int lane) {
    unsigned char* ws = a.ws;
    LAS float* scr = (LAS float*)(lds + wave * 16384);
    constexpr int T0 = 1280, T1 = T0 + 512, T2 = T1 + 2816, T3 = T2 + 1408, T4 = T3 + 768, T5 = T4 + 512, T6 = T5 + 2816, T7 = T6 + 1408;
    constexpr int G_END = T7 + 3072, K0C = G_END + 512, K1C = K0C + 512, V0C = K1C + 256, V1C = V0C + 128, RP = V1C + 16, TOTAL = RP + 1;
    for (int it = gw; it < TOTAL; it += NGW) {
        if (it < T7) {
            if (it < T0) p0_transpose_item(a.in[11], 1024, NIN0, (bf16*)(ws + WS_WIN0), 1, scr, it, lane);
            else if (it < T1) p0_transpose_item(a.in[18], 1024, 1024, (bf16*)(ws + WS_WOUT0), 0, scr, it - T0, lane);
            else if (it < T2) p0_transpose_item(a.in[19], 1024, NGU, (bf16*)(ws + WS_WGU0), 2, scr, it - T1, lane);
            else if (it < T3) p0_transpose_item(a.in[20], FH, 1024, (bf16*)(ws + WS_WDN0), 0, scr, it - T2, lane);
            else if (it < T4) p0_transpose_item(a.in[24], 1024, NQKV1, (bf16*)(ws + WS_WQKV1), 0, scr, it - T3, lane);
            else if (it < T5) p0_transpose_item(a.in[26], 1024, 1024, (bf16*)(ws + WS_WOUT1), 0, scr, it - T4, lane);
            else if (it < T6) p0_transpose_item(a.in[27], 1024, NGU, (bf16*)(ws + WS_WGU1), 2, scr, it - T5, lane);
            else p0_transpose_item(a.in[28], FH, 1024, (bf16*)(ws + WS_WDN1), 0, scr, it - T6, lane);
        } else if (it < G_END) {
            const int r = it - T7, layer = r / 1536, q = r % 1536, strip = q % 24, kc = q / 24, k0 = kc * 16;
            const float* W = a.in[layer ? 21 : 8]; const float* bias = a.in[layer ? 22 : 9];
            const float* c = a.in[6]; const float* cx = a.in[7];
            const int col = strip * 256 + lane * 4;
            f32x4 a0 = {0.f, 0.f, 0.f, 0.f}, a1 = a0, a2 = a0;
#pragma unroll 4
            for (int rr = 0; rr < 16; ++rr) { const int k = k0 + rr; const f32x4 w = *(const f32x4*)(W + (size_t)k * 6144 + col);
                a0 = a0 + w * fsilu(c[k]); a1 = a1 + w * fsilu(c[1024 + k]); a2 = a2 + w * fsilu(cx[k]); }
            if (kc == 0) { const f32x4 b = *(const f32x4*)(bias + col); a0 = a0 + b; a1 = a1 + b; a2 = a2 + b; }
            float* m = (float*)(ws + WS_MOD) + layer * 3 * 6144 + col;
#pragma unroll
            for (int e = 0; e < 4; ++e) { unsafeAtomicAdd(m + e, a0[e]); unsafeAtomicAdd(m + 6144 + e, a1[e]); unsafeAtomicAdd(m + 2 * 6144 + e, a2[e]); }
        } else if (it < K0C) {
            const int r = it - G_END, b = r >> 8, t = r & 255; const float* s = a.in[2] + (size_t)r * 512 + lane * 8;
            const f32x4 v0 = *(const f32x4*)s, v1 = *(const f32x4*)(s + 4);
            *(v4u*)((bf16*)(ws + WS_K0) + (size_t)(MP + b * 1280 + 1024 + t) * 512 + lane * 8) = pack8(v0, v1);
        } else if (it < K1C) {
            const int r = it - K0C, b = r >> 8, t = r & 255; const f32x4 v0 = *(const f32x4*)(a.in[4] + (size_t)r * 256 + lane * 4);
            v2u w; w.x = cvt_pk_bf16(v0[0], v0[1]); w.y = cvt_pk_bf16(v0[2], v0[3]);
            *(v2u*)((bf16*)(ws + WS_K1) + (size_t)(MP + b * 1280 + 1024 + t) * 256 + lane * 4) = w;
        } else if (it < V0C) {
            const int r = it - K1C, dvb = r & 7, h = (r >> 3) & 3, tb = (r >> 5) & 3, b = r >> 7;
            const float* s = a.in[3] + ((size_t)(b * 256 + tb * 64 + lane) * 4 + h) * 128 + dvb * 16;
            bf16* d = (bf16*)(ws + WS_VT0S) + ((size_t)((b * 4 + h) * 128 + dvb * 16)) * 1280 + 1024 + tb * 64 + lane;
#pragma unroll
            for (int q = 0; q < 4; ++q) { const f32x4 v = *(const f32x4*)(s + 4 * q);
#pragma unroll
                for (int e = 0; e < 4; ++e) d[(size_t)(4 * q + e) * 1280] = (bf16)f2bf(v[e]); }
        } else if (it < V1C) {
            const int r = it - V0C, db = r & 3, h = (r >> 2) & 3, tb = (r >> 4) & 3, b = r >> 6;
            const float* s = a.in[5] + ((size_t)(b * 256 + tb * 64 + lane) * 4 + h) * 64 + db * 16;
            bf16* d = (bf16*)(ws + WS_VT1S) + ((size_t)((b * 4 + h) * 64 + db * 16)) * 1280 + 1024 + tb * 64 + lane;
#pragma unroll
            for (int q = 0; q < 4; ++q) { const f32x4 v = *(const f32x4*)(s + 4 * q);
#pragma unroll
                for (int e = 0; e < 4; ++e) d[(size_t)(4 * q + e) * 1280] = (bf16)f2bf(v[e]); }
        } else if (it < RP) {
            const int e = (it - V1C) * 64 + lane, pos = e >> 4, i = e & 15;
            const float inv = 1.0f / powf(10000.0f, (float)(2 * i) / 32.0f), ang = (float)pos * inv;
            ((float*)(ws + WS_ROPEC))[e] = cosf(ang); ((float*)(ws + WS_ROPES))[e] = sinf(ang);
        } else {
            const float* lf = a.in[16];
            const float s1 = wave_sum(lf[lane] * lf[64 + lane]), s2 = wave_sum(lf[128 + lane] * lf[192 + lane]);
            if (lane == 0) *(float*)(ws + WS_LAM) = expf(s1) - expf(s2) + 0.2f;
        }
    }
}

__global__ void __launch_bounds__(512, 2) mega_fwd(Args a) {
    extern __shared__ __attribute__((aligned(16))) unsigned char lds_raw[];
    LAS unsigned char* lds = (LAS unsigned char*)lds_raw;
    cg::grid_group grid = cg::this_grid();
    const int tid = threadIdx.x, lane = tid & 63, wave = __builtin_amdgcn_readfirstlane(tid >> 6);
    const int G = gridDim.x, bx = blockIdx.x, gw = bx * 8 + wave, NGW = G * 8;
    unsigned char* ws = a.ws; float* out = a.out;
    const float* mod0 = (const float*)(ws + WS_MOD); const float* mod1 = mod0 + 3 * 6144;
    bf16* Hb = (bf16*)(ws + WS_H); bf16* CAT = (bf16*)(ws + WS_CAT); bf16* MIX = (bf16*)(ws + WS_MIX); bf16* ACT = (bf16*)(ws + WS_ACT);
    const float* rc = (const float*)(ws + WS_ROPEC); const float* rs = (const float*)(ws + WS_ROPES);
    float* Y = out + O_Y;
    const int lo = a.ph_lo, hi = a.ph_hi;
#ifndef MK_NOCONV
#define MK_NOCONV 0
#endif
#ifndef MK_NOATT0
#define MK_NOATT0 0
#endif
#ifndef MK_PHMASK
#define MK_PHMASK 0xffffu
#endif
#define IN(k) (((MK_PHMASK >> (k)) & 1u) && lo <= (k) && (k) < hi)
#define SEAM(k) do { if (IN(k) && IN((k) + 1)) grid.sync(); } while (0)
#define GEMM(EpiT, E, Ap, Bp, Nn, Kk) do { pg8::Gemm g{(const pg8::bf16_t*)(Ap), (const pg8::bf16_t*)(Bp), MT, (Nn), (Kk)}; pg8::StaticOrder S; S.init(MT, (Nn), G, bx); \
        pg8::gemm_phase<EpiT, pg8::StaticOrder, true, true>(lds, g, S, E); } while (0)

    if (IN(0)) prep_phase(a, lds, gw, NGW, wave, lane);
    SEAM(0);
    if (IN(1)) rowwise_phase(gw, NGW, lane, a.in[0], a.in[1], nullptr, nullptr, nullptr, nullptr, a.in[10], mod0, 1024, 0, Hb);
    SEAM(1);
    if (IN(2)) { EpiIn0 E{(bf16*)(ws + WS_Z), (bf16*)(ws + WS_Q0), (bf16*)(ws + WS_K0), (bf16*)(ws + WS_VT0P), (bf16*)(ws + WS_VT0S), out, rc, rs};
        GEMM(EpiIn0, E, Hb, ws + WS_WIN0, NIN0, 1024); }
    SEAM(2);
    if (IN(3)) {
        const float lam = *(const float*)(ws + WS_LAM);
        const bf16* Q0 = (const bf16*)(ws + WS_Q0); const bf16* K0 = (const bf16*)(ws + WS_K0);
        const bool split = G >= 128;
        int u = bx, stride = G;
        if (split && bx >= 64) { u = 64 + (bx - 64); stride = G - 64; }
        for (; u < 640; u += stride) {
            if (u < 320 && !MK_NOATT0) { int row0, krow0, ldv, nt; const bf16* vt; int b, h;
                if (u < 64) { const int bh = u & 7, qb = u >> 3; b = bh >> 2; h = bh & 3; row0 = MP + b * 1024 + qb * 128; krow0 = MP + b * 1280; ldv = 1280; nt = 20; vt = (const bf16*)(ws + WS_VT0S); }
                else { const int p = u - 64, qb = p & 1, bh = p >> 1; b = bh >> 2; h = bh & 3; row0 = b * 256 + qb * 128; krow0 = b * 256; ldv = 256; nt = 4; vt = (const bf16*)(ws + WS_VT0P); }
                attn_unit<2, 128>(lds, tid, Q0 + (size_t)row0 * 512 + h * 128, 512, K0 + (size_t)krow0 * 512 + h * 128, 512,
                                  vt + (size_t)(b * 4 + h) * 128 * ldv, ldv, 0, nt, 0, 0, false, 0, lam, a.in[17], 0.f, CAT + (size_t)row0 * 1024 + 512 + h * 128, 1024);
                if (split && u < 64) break;
            } else if (!MK_NOCONV) conv_unit(lds, tid, u - 320, (const bf16*)(ws + WS_Z), a.in[12], a.in[13], a.in[14], a.in[15], CAT);
        }
    }
    SEAM(3);
    if (IN(4)) { EpiStore E{MIX, 1024}; GEMM(EpiStore, E, CAT, ws + WS_WOUT0, 1024, 1024); }
    SEAM(4);
    if (IN(5)) rowwise_phase(gw, NGW, lane, a.in[0], a.in[1], MIX, a.in[10] + 1024, mod0 + 2048, Y, a.in[10] + 2048, mod0, 4096, 3072, Hb);
    SEAM(5);
    if (IN(6)) { EpiSwiglu E{ACT}; GEMM(EpiSwiglu, E, Hb, ws + WS_WGU0, NGU, 1024); }
    SEAM(6);
    if (IN(7)) { EpiStore E{MIX, 1024}; GEMM(EpiStore, E, ACT, ws + WS_WDN0, 1024, FH); }
    SEAM(7);
    if (IN(8)) rowwise_phase(gw, NGW, lane, Y, Y + (size_t)MP * D, MIX, a.in[10] + 3072, mod0 + 5120, Y, a.in[23], mod1, 1024, 0, Hb);
    SEAM(8);
    if (IN(9)) { EpiQkv1 E{(bf16*)(ws + WS_Q1), (bf16*)(ws + WS_K1), (bf16*)(ws + WS_VT1P), (bf16*)(ws + WS_VT1S), out, rc, rs};
        GEMM(EpiQkv1, E, Hb, ws + WS_WQKV1, NQKV1, 1024); }
    SEAM(9);
    if (IN(10)) {
        const bf16* Q1 = (const bf16*)(ws + WS_Q1); const bf16* K1 = (const bf16*)(ws + WS_K1);
        for (int u = bx; u < 1280; u += G) {
            int row0, krow0, ldv, b0, nb, qpos0, qh, bq; const bf16* vt; bool mk;
            if (u < 256) { const int qb = u >> 5, rest = u & 31; bq = rest >> 4; qh = rest & 15; row0 = MP + bq * 1024 + qb * 128; krow0 = MP + bq * 1280; ldv = 1280; vt = (const bf16*)(ws + WS_VT1S);
                const int wlo = (qb * 128 - 128) < 0 ? 0 : qb * 128 - 128, whi = (qb * 128 + 256) > 1024 ? 1024 : qb * 128 + 256; b0 = wlo; nb = (whi - wlo) / 64; qpos0 = qb * 128; mk = true; }
            else { const int p = u - 256, qb = p & 1, rest = p >> 1; qh = rest & 15; bq = rest >> 4; row0 = bq * 256 + qb * 128; krow0 = bq * 256; ldv = 256; vt = (const bf16*)(ws + WS_VT1P); b0 = 0; nb = 0; qpos0 = 0; mk = false; }
            const int hk = qh >> 2;
            attn_unit<1, 64>(lds, tid, Q1 + (size_t)row0 * 1024 + qh * 64, 1024, K1 + (size_t)krow0 * 256 + hk * 64, 256, vt + (size_t)(bq * 4 + hk) * 64 * ldv, ldv,
                             mk ? 1024 : 0, 4, b0, nb, mk, qpos0, 0.f, nullptr, a.in[25][qh], CAT + (size_t)row0 * 1024 + qh * 64, 1024);
        }
    }
    SEAM(10);
    if (IN(11)) { EpiStore E{MIX, 1024}; GEMM(EpiStore, E, CAT, ws + WS_WOUT1, 1024, 1024); }
    SEAM(11);
    if (IN(12)) rowwise_phase(gw, NGW, lane, Y, Y + (size_t)MP * D, MIX, a.in[23] + 1024, mod1 + 2048, Y, a.in[23] + 2048, mod1, 4096, 3072, Hb);
    SEAM(12);
    if (IN(13)) { EpiSwiglu E{ACT}; GEMM(EpiSwiglu, E, Hb, ws + WS_WGU1, NGU, 1024); }
    SEAM(13);
    if (IN(14)) { EpiStore E{MIX, 1024}; GEMM(EpiStore, E, ACT, ws + WS_WDN1, 1024, FH); }
    SEAM(14);
    if (IN(15)) rowwise_phase(gw, NGW, lane, Y, Y + (size_t)MP * D, MIX, a.in[23] + 3072, mod1 + 5120, Y, nullptr, nullptr, 0, 0, nullptr);
#undef IN
#undef SEAM
#undef GEMM
}

extern "C" void kernel_launch(void* const* d_in, const int* in_sizes, int n_in, void* d_out, int out_size, void* d_ws, size_t ws_size, hipStream_t stream) {
    static int grid = 0;
    if (grid == 0) {
        if (n_in != 29 || ws_size < WS_END) { fprintf(stderr, "kernel_launch: unexpected n_in %d / ws %zu\n", n_in, ws_size); grid = -1; return; }
        int dev = 0, cus = 0, per_cu = 0;
        (void)hipGetDevice(&dev); (void)hipDeviceGetAttribute(&cus, hipDeviceAttributeMultiprocessorCount, dev);
        if (hipFuncSetAttribute((const void*)mega_fwd, hipFuncAttributeMaxDynamicSharedMemorySize, LDS_BYTES) != hipSuccess) { fprintf(stderr, "kernel_launch: hipFuncSetAttribute failed\n"); grid = -1; return; }
        if (hipOccupancyMaxActiveBlocksPerMultiprocessor(&per_cu, (const void*)mega_fwd, 512, LDS_BYTES) != hipSuccess || per_cu < 1) { fprintf(stderr, "kernel_launch: occupancy query says %d\n", per_cu); per_cu = 1; }
        (void)hipGetLastError();
        if (cus <= 0) cus = 256;
        grid = cus * (per_cu > 1 ? 1 : per_cu);
    }
    if (grid < 0) return;
    (void)hipMemsetAsync((char*)d_ws + WS_MOD, 0, 2 * 3 * 6144 * sizeof(float), stream);
    Args a{};
    for (int i = 0; i < 29; ++i) a.in[i] = (const float*)d_in[i];
    a.out = (float*)d_out; a.ws = (unsigned char*)d_ws;
#if MK_PER_PHASE
    for (int p = 0; p < NPH; ++p) { a.ph_lo = p; a.ph_hi = p + 1; hipLaunchKernelGGL(mega_fwd, dim3(grid), dim3(512), LDS_BYTES, stream, a); }
#else
    a.ph_lo = 0; a.ph_hi = NPH;
    void* args[] = {&a};
    hipError_t e = hipLaunchCooperativeKernel((const void*)mega_fwd, dim3(grid), dim3(512), args, LDS_BYTES, stream);
    if (e != hipSuccess) fprintf(stderr, "kernel_launch: cooperative launch failed: %s (grid %d)\n", hipGetErrorString(e), grid);
#endif
}
```

```cpp
#include <hip/hip_runtime.h>
#include <hip/hip_cooperative_groups.h>
#include <cstdio>
#include <cstdint>
namespace cg = cooperative_groups;

namespace pg8 {
#define PG8_LAS __attribute__((address_space(3)))
typedef unsigned short bf16_t;
typedef short bf16x8 __attribute__((ext_vector_type(8)));
typedef float f32x4 __attribute__((ext_vector_type(4)));
typedef unsigned u32x4 __attribute__((ext_vector_type(4)));
constexpr int BM = 256, BK = 64, HALF = 128, HTB = HALF * BK * 2  , STAGE_BYTES = 8 * HTB, NXCD = 8, WGM = 8;

__host__ __device__ __forceinline__ int lds_byte(int r, int c) { const int st = (r >> 4) * 2 + (c >> 5), rr = r & 15, cc = c & 31, ob = rr * 64 + cc * 2; return st * 1024 + (ob ^ (((ob >> 9) & 1) << 5)); }
__host__ __device__ __forceinline__ void stage_rc(int b, int& R, int& C) { const int st = b / 1024, sb = b % 1024, swz = sb ^ (((sb >> 9) & 1) << 5); R = (st >> 1) * 16 + swz / 64; C = (st & 1) * 32 + (swz % 64) / 2; }
__host__ __device__ __forceinline__ int perm32(int rho) { const int n = rho >> 4, i = rho & 15; return 8 * (i >> 2) + 4 * n + (i & 3); }

struct Unit { int pm, pn; };
struct Gemm { const bf16_t* A; const bf16_t* Bt; int M, N, K; };

struct StaticOrder {
    int nM, nN, nwg, G, c;
    __host__ __device__ void init(int M, int N, int G_, int c_) { nM = M / BM; nN = N / BM; nwg = nM * nN; G = G_; c = c_; }
    __host__ __device__ bool next(int i, Unit& u) const {
        const long L = (long)i * G + c; if (L >= nwg) return false;
        int wgid = (int)L; { const int q = nwg / NXCD, r = nwg % NXCD, xcd = wgid % NXCD, off = wgid / NXCD; wgid = (xcd < r ? xcd * (q + 1) : r * (q + 1) + (xcd - r) * q) + off; }
        const int nig = WGM * nN, gid = wgid / nig, fm = gid * WGM, gsz = (nM - fm) < WGM ? (nM - fm) : WGM;
        u.pm = fm + ((wgid % nig) % gsz); u.pn = (wgid % nig) / gsz; return true;
    }
    __device__ __forceinline__ void a_ready(const Unit&) const {}
    __device__ __forceinline__ void done(const Unit&) const {}
};

__device__ __forceinline__ unsigned cvt_pk_bf16(float lo, float hi) { unsigned r; asm volatile("v_cvt_pk_bf16_f32 %0, %1, %2" : "=v"(r) : "v"(lo), "v"(hi)); return r; }
typedef float f32x2 __attribute__((ext_vector_type(2)));
template <class Epi, class Sched, bool ALIGN_EPI = false, bool SP2 = false>
__device__ __forceinline__ void gemm_phase(PG8_LAS unsigned char* lds, const Gemm g, const Sched& S, const Epi& E) {
    const int tid = threadIdx.x, wid = __builtin_amdgcn_readfirstlane(tid >> 6), lane = tid & 63, wr = wid >> 2, wc = wid & 3, fr = lane & 15, fq = lane >> 4;
    const int K = g.K, nt = K / BK;
    unsigned voffA[2], voffB[2];
#pragma unroll
    for (int i = 0; i < 2; ++i) { int R, C; stage_rc(tid * 16 + i * 8192, R, C); const int Rb = Epi::PERM ? ((R & ~31) + perm32(R & 31)) : R;
        voffA[i] = (unsigned)(R * K + C) * 2u; voffB[i] = (unsigned)(Rb * K + C) * 2u; }
    const size_t kstep = (size_t)(BK * 2);
    const size_t hstep = (size_t)HALF * K * 2;
    const size_t tstep = 2 * hstep;
    const unsigned ldsw = (unsigned)wid * 1024u;
    const int aoff = lds_byte(wr * 64 + fr, fq * 8), boff = lds_byte(wc * 32 + fr, fq * 8);
#define PG8_SA(b, h) (((b) * 2 + (h)) * HTB)
#define PG8_SB(b, h) ((4 + (b) * 2 + (h)) * HTB)
#define PG8_STAGE(bufoff, gbase, voff) do { _Pragma("unroll") for (int _i = 0; _i < 2; ++_i) \
        __builtin_amdgcn_global_load_lds((const unsigned*)((const char*)(gbase) + (voff)[_i]), (PG8_LAS unsigned*)(lds + (bufoff) + ldsw + _i * 8192), 16, 0, 0); } while (0)
#define PG8_LDA(dst, b, h) do { _Pragma("unroll") for (int m = 0; m < 4; ++m) _Pragma("unroll") for (int k = 0; k < 2; ++k) dst[m][k] = *(const PG8_LAS bf16x8*)(lds + PG8_SA(b, h) + aoff + m * 2048 + k * 1024); } while (0)
#define PG8_LDB(dst, b, h) do { _Pragma("unroll") for (int n = 0; n < 2; ++n) _Pragma("unroll") for (int k = 0; k < 2; ++k) dst[n][k] = *(const PG8_LAS bf16x8*)(lds + PG8_SB(b, h) + boff + n * 2048 + k * 1024); } while (0)
#define PG8_MMA(ai, bj, At, Bt) do { __builtin_amdgcn_s_setprio(1); _Pragma("unroll") for (int m = 0; m < 4; ++m) _Pragma("unroll") for (int n = 0; n < 2; ++n) _Pragma("unroll") for (int k = 0; k < 2; ++k) \
        acc[ai][bj][m][n] = __builtin_amdgcn_mfma_f32_16x16x32_bf16(Bt[n][k], At[m][k], acc[ai][bj][m][n], 0, 0, 0); __builtin_amdgcn_s_setprio(0); } while (0)
#define PG8_WAIT_V(n) asm volatile("s_waitcnt vmcnt(" #n ")" ::: "memory")
#define PG8_WAIT_L(n) asm volatile("s_waitcnt lgkmcnt(" #n ")" ::: "memory")
#define PG8_BAR __builtin_amdgcn_s_barrier()
#define PG8_SCHED __builtin_amdgcn_sched_barrier(0)
    Unit cur, nxt; int ui = 0;
    if (!S.next(0, cur)) return;
    f32x4 acc[2][2][4][2];
#pragma unroll
    for (int a = 0; a < 2; ++a)
#pragma unroll
        for (int b = 0; b < 2; ++b)
#pragma unroll
            for (int m = 0; m < 4; ++m)
#pragma unroll
                for (int n = 0; n < 2; ++n) acc[a][b][m][n] = (f32x4){0.f, 0.f, 0.f, 0.f};
    bf16x8 At[4][2], B0[2][2], B1[2][2];
    const char* cA = (const char*)g.A + (size_t)cur.pm * tstep; const char* cB = (const char*)g.Bt + (size_t)cur.pn * tstep;
    S.a_ready(cur);
    if constexpr (SP2) {
        PG8_STAGE(PG8_SB(0, 0), cB, voffB); PG8_STAGE(PG8_SB(0, 1), cB + hstep, voffB); PG8_STAGE(PG8_SA(0, 0), cA, voffA); PG8_STAGE(PG8_SA(0, 1), cA + hstep, voffA);
        if (wr == 1) PG8_BAR;
        PG8_WAIT_V(2); PG8_BAR;
        PG8_STAGE(PG8_SB(1, 0), cB + kstep, voffB); PG8_STAGE(PG8_SA(1, 0), cA + kstep, voffA); PG8_STAGE(PG8_SB(1, 1), cB + hstep + kstep, voffB);
        PG8_WAIT_V(6); PG8_BAR;
    } else {
        PG8_STAGE(PG8_SB(0, 0), cB, voffB); PG8_STAGE(PG8_SA(0, 0), cA, voffA); PG8_STAGE(PG8_SB(0, 1), cB + hstep, voffB); PG8_STAGE(PG8_SA(0, 1), cA + hstep, voffA);
        if (wr == 1) PG8_BAR;
        PG8_WAIT_V(4); PG8_BAR;
        PG8_STAGE(PG8_SB(1, 0), cB + kstep, voffB); PG8_STAGE(PG8_SA(1, 0), cA + kstep, voffA); PG8_STAGE(PG8_SB(1, 1), cB + hstep + kstep, voffB);
        PG8_WAIT_V(6); PG8_BAR;
    }
    for (;;) {
        const bool has_next = S.next(ui + 1, nxt);
        const char* nA = has_next ? (const char*)g.A + (size_t)nxt.pm * tstep : cA; const char* nB = has_next ? (const char*)g.Bt + (size_t)nxt.pn * tstep : cB;
        for (int t = 0; t < nt; t += 2) {
            const bool last = (t == nt - 2);
            const char* a1 = cA + (size_t)(t + 1) * kstep;
            const char* a2 = last ? nA : cA + (size_t)(t + 2) * kstep; const char* b2 = last ? nB : cB + (size_t)(t + 2) * kstep;
            const char* a3 = a2 + kstep; const char* b3 = b2 + kstep;
            if (last && has_next) S.a_ready(nxt);
            if constexpr (SP2) {
            PG8_LDB(B0, 0, 0); PG8_LDB(B1, 0, 1); PG8_SCHED; PG8_LDA(At, 0, 0); PG8_STAGE(PG8_SA(1, 1), a1 + hstep, voffA);
            PG8_WAIT_V(8); PG8_WAIT_L(0); PG8_BAR; PG8_MMA(0, 0, At, B0); PG8_MMA(0, 1, At, B1); PG8_BAR; PG8_SCHED;
            PG8_LDA(At, 0, 1); PG8_STAGE(PG8_SB(0, 0), b2, voffB); PG8_STAGE(PG8_SB(0, 1), b2 + hstep, voffB); PG8_STAGE(PG8_SA(0, 0), a2, voffA);
            PG8_WAIT_V(8); PG8_WAIT_L(0); PG8_BAR; PG8_MMA(1, 0, At, B0); PG8_MMA(1, 1, At, B1); PG8_BAR; PG8_SCHED;
            PG8_LDB(B0, 1, 0); PG8_LDB(B1, 1, 1); PG8_SCHED; PG8_LDA(At, 1, 0); PG8_STAGE(PG8_SA(0, 1), a2 + hstep, voffA);
            PG8_WAIT_V(8); PG8_WAIT_L(0); PG8_BAR; PG8_MMA(0, 0, At, B0); PG8_MMA(0, 1, At, B1); PG8_BAR; PG8_SCHED;
            PG8_LDA(At, 1, 1); PG8_STAGE(PG8_SB(1, 0), b3, voffB); PG8_STAGE(PG8_SB(1, 1), b3 + hstep, voffB); PG8_STAGE(PG8_SA(1, 0), a3, voffA);
            PG8_WAIT_V(8); PG8_WAIT_L(0); PG8_BAR; PG8_MMA(1, 0, At, B0); PG8_MMA(1, 1, At, B1); PG8_BAR; PG8_SCHED;
            } else {
            PG8_LDB(B0, 0, 0); PG8_SCHED; PG8_LDA(At, 0, 0); PG8_STAGE(PG8_SA(1, 1), a1 + hstep, voffA);
            PG8_WAIT_L(8); PG8_BAR; PG8_WAIT_L(0); PG8_MMA(0, 0, At, B0); PG8_BAR; PG8_SCHED;
            PG8_LDB(B1, 0, 1); PG8_STAGE(PG8_SB(0, 0), b2, voffB);
            PG8_BAR; PG8_WAIT_L(0); PG8_MMA(0, 1, At, B1); PG8_BAR;
            PG8_LDA(At, 0, 1); PG8_STAGE(PG8_SA(0, 0), a2, voffA);
            PG8_BAR; PG8_WAIT_L(0); PG8_MMA(1, 0, At, B0); PG8_BAR; PG8_SCHED;
            PG8_STAGE(PG8_SB(0, 1), b2 + hstep, voffB);
            PG8_WAIT_V(6); PG8_BAR; PG8_MMA(1, 1, At, B1); PG8_BAR;
            PG8_LDB(B0, 1, 0); PG8_SCHED; PG8_LDA(At, 1, 0); PG8_STAGE(PG8_SA(0, 1), a2 + hstep, voffA);
            PG8_WAIT_L(8); PG8_BAR; PG8_WAIT_L(0); PG8_MMA(0, 0, At, B0); PG8_BAR; PG8_SCHED;
            PG8_LDB(B1, 1, 1); PG8_STAGE(PG8_SB(1, 0), b3, voffB);
            PG8_BAR; PG8_WAIT_L(0); PG8_MMA(0, 1, At, B1); PG8_BAR;
            PG8_LDA(At, 1, 1); PG8_STAGE(PG8_SA(1, 0), a3, voffA);
            PG8_BAR; PG8_WAIT_L(0); PG8_MMA(1, 0, At, B0); PG8_BAR; PG8_SCHED;
            PG8_STAGE(PG8_SB(1, 1), b3 + hstep, voffB);
            PG8_WAIT_V(6); PG8_BAR; PG8_MMA(1, 1, At, B1); PG8_BAR;
            }
        }
        if constexpr (ALIGN_EPI) { if (wr == 0) PG8_BAR; }
        if constexpr (!Epi::AFTER_DRAIN) { E(acc, cur, wr, wc, fr, fq); S.done(cur); }
        if (!has_next) break;
#pragma unroll
        for (int a = 0; a < 2; ++a)
#pragma unroll
            for (int b = 0; b < 2; ++b)
#pragma unroll
                for (int m = 0; m < 4; ++m)
#pragma unroll
                    for (int n = 0; n < 2; ++n) acc[a][b][m][n] = (f32x4){0.f, 0.f, 0.f, 0.f};
        cur = nxt; cA = nA; cB = nB; ++ui;
        if constexpr (ALIGN_EPI) { if (wr == 1) PG8_BAR; }
    }
    PG8_WAIT_V(0);
    if constexpr (!ALIGN_EPI) { if (wr == 0) PG8_BAR; }
    PG8_BAR;
    if constexpr (Epi::AFTER_DRAIN) { E.fused(acc, cur, wr, wc, fr, fq, lds, wid, lane); S.done(cur); }
#undef PG8_SA
#undef PG8_SB
#undef PG8_STAGE
#undef PG8_LDA
#undef PG8_LDB
#undef PG8_MMA
#undef PG8_WAIT_V
#undef PG8_WAIT_L
#undef PG8_BAR
#undef PG8_SCHED
}
}

#ifndef MK_PER_PHASE
#define MK_PER_PHASE 0
#endif
#define GAS __attribute__((address_space(1)))
#define LAS __attribute__((address_space(3)))
typedef unsigned short bf16;
typedef unsigned v4u __attribute__((ext_vector_type(4)));
typedef unsigned v2u __attribute__((ext_vector_type(2)));
using pg8::f32x4; using pg8::bf16x8; using pg8::Unit; using pg8::cvt_pk_bf16;

constexpr int D = 1024, MP = 8192, MS = 2048, MT = 10240;
constexpr int NIN0 = 2560, NQKV1 = 1536, FH = 2816, NGU = 5632;
constexpr float EPS = 1e-6f, LOG2E = 1.4426950408889634f;
constexpr int NPH = 16;
constexpr size_t O_Y = 0, O_NK0 = 10485760, O_NV0 = 14680064, O_NK1 = 18874368, O_NV1 = 20971520;
constexpr size_t MiB = 1u << 20;
constexpr size_t WS_MOD = 0;
constexpr size_t WS_BAR = 524288, WS_ZERO_BYTES = 614400;
constexpr size_t WS_LAM = 262144;
constexpr size_t WS_ROPEC = 327680, WS_ROPES = 327680 + 4096;
constexpr size_t WS_WIN0 = 1 * MiB, WS_WOUT0 = 6 * MiB, WS_WGU0 = 8 * MiB, WS_WDN0 = 19 * MiB;
constexpr size_t WS_WQKV1 = 25 * MiB, WS_WOUT1 = 28 * MiB, WS_WGU1 = 30 * MiB, WS_WDN1 = 41 * MiB;
constexpr size_t WS_H = 47 * MiB, WS_Z = 67 * MiB, WS_Q0 = 77 * MiB, WS_Q1 = 67 * MiB;
constexpr size_t WS_K0 = 87 * MiB, WS_VT0P = 98 * MiB, WS_VT0S = 106 * MiB;
constexpr size_t WS_CAT = 109 * MiB, WS_MIX = 129 * MiB, WS_ACT = 149 * MiB;
constexpr size_t WS_K1 = 204 * MiB, WS_VT1P = 210 * MiB, WS_VT1S = 214 * MiB, WS_END = 216 * MiB;
constexpr int LDS_BYTES = 147456;

struct Args { const float* in[29]; float* out; unsigned char* ws; int ph_lo, ph_hi; };

__device__ __forceinline__ unsigned f2bf(float f) { unsigned u = __builtin_bit_cast(unsigned, f); return (u + 0x7fffu + ((u >> 16) & 1u)) >> 16; }
__device__ __forceinline__ unsigned pk2(float lo, float hi) { return f2bf(lo) | (f2bf(hi) << 16); }
__device__ __forceinline__ float bflo(unsigned w) { return __builtin_bit_cast(float, w << 16); }
__device__ __forceinline__ float bfhi(unsigned w) { return __builtin_bit_cast(float, w & 0xffff0000u); }
__device__ __forceinline__ v4u pack8(f32x4 a, f32x4 b) { v4u w; w.x = cvt_pk_bf16(a[0], a[1]); w.y = cvt_pk_bf16(a[2], a[3]); w.z = cvt_pk_bf16(b[0], b[1]); w.w = cvt_pk_bf16(b[2], b[3]); return w; }
__device__ __forceinline__ float fsigmoid(float x) { return __builtin_amdgcn_rcpf(1.f + __expf(-x)); }
__device__ __forceinline__ float wave_sum(float v) {
#pragma unroll
    for (int o = 1; o < 64; o <<= 1) v += __shfl_xor(v, o);
    return v;
}

struct EpiStore {
    static constexpr bool PERM = true, AFTER_DRAIN = false;
    bf16* O; int ldc;
    __device__ __forceinline__ void operator()(const f32x4 (&acc)[2][2][4][2], const Unit& u, int wr, int wc, int fr_in, int fq_in) const {
        int fr = fr_in, fq = fq_in; asm volatile("" : "+v"(fr), "+v"(fq));
        const int row0 = u.pm * 256 + wr * 64 + fr, col0 = u.pn * 256 + wc * 32 + 8 * fq;
#pragma unroll
        for (int ai = 0; ai < 2; ++ai)
#pragma unroll
            for (int m = 0; m < 4; ++m) { bf16* rowp = O + (size_t)(row0 + ai * 128 + m * 16) * ldc + col0;
#pragma unroll
                for (int bj = 0; bj < 2; ++bj) *(v4u*)(rowp + bj * 128) = pack8(acc[ai][bj][m][0], acc[ai][bj][m][1]); }
    }
};
struct EpiSwiglu {
    static constexpr bool PERM = true, AFTER_DRAIN = false;
    bf16* O;
    __device__ __forceinline__ void operator()(const f32x4 (&acc)[2][2][4][2], const Unit& u, int wr, int wc, int fr_in, int fq_in) const {
        int fr = fr_in, fq = fq_in; asm volatile("" : "+v"(fr), "+v"(fq));
        const int row0 = u.pm * 256 + wr * 64 + fr, col0 = u.pn * 128 + wc * 32 + 8 * fq;
#pragma unroll
        for (int ai = 0; ai < 2; ++ai)
#pragma unroll
            for (int m = 0; m < 4; ++m) {
                f32x4 r[2];
#pragma unroll
                for (int n = 0; n < 2; ++n)
#pragma unroll
                    for (int e = 0; e < 4; ++e) { const float g = acc[ai][0][m][n][e]; r[n][e] = g * fsigmoid(g) * acc[ai][1][m][n][e]; }
                *(v4u*)(O + (size_t)(row0 + ai * 128 + m * 16) * FH + col0) = pack8(r[0], r[1]); }
    }
};
__device__ __forceinline__ void rope4(f32x4& v, int i0, float sg, const float* rc, const float* rs) {
    const f32x4 c = *(const f32x4*)(rc + i0), s = *(const f32x4*)(rs + i0);
    f32x4 p;
#pragma unroll
    for (int e = 0; e < 4; ++e) p[e] = __shfl_xor(v[e], 32);
    v = v * c + (p * s) * sg;
}
__device__ __forceinline__ void rope8(f32x4& v0, f32x4& v1, int t, int wc, int fq, const float* rc, const float* rs) {
    const int pos = (wc & 1) ? (t & 63) : (t >> 6);
    const int i0 = pos * 16 + 8 * (fq & 1);
    const float sg = (fq & 2) ? 1.f : -1.f;
    rope4(v0, i0, sg, rc, rs); rope4(v1, i0 + 4, sg, rc, rs);
}
struct EpiIn0 {
    static constexpr bool PERM = true, AFTER_DRAIN = false;
    bf16 *Z, *Q0, *K0, *VTP, *VTS; float* out; const float *rc, *rs;
    __device__ __forceinline__ void operator()(const f32x4 (&acc)[2][2][4][2], const Unit& u, int wr, int wc, int fr_in, int fq_in) const {
        int fr = fr_in, fq = fq_in; asm volatile("" : "+v"(fr), "+v"(fq));
        const int pn = u.pn, pm = u.pm; const bool samp = pm >= 32;
        const int sb = (pm - 32) >> 2, tq = ((pm - 32) & 3) * 256;
        if (pn < 4) {
            const int col0 = pn * 128 + wc * 32 + 8 * fq;
#pragma unroll
            for (int ai = 0; ai < 2; ++ai)
#pragma unroll
                for (int m = 0; m < 4; ++m) { const int grow = pm * 256 + ai * 128 + wr * 64 + m * 16 + fr;
                    f32x4 r[2];
#pragma unroll
                    for (int n = 0; n < 2; ++n)
#pragma unroll
                        for (int e = 0; e < 4; ++e) r[n][e] = acc[ai][0][m][n][e] * fsigmoid(acc[ai][1][m][n][e]);
                    *(v4u*)(Z + (size_t)grow * 512 + col0) = pack8(r[0], r[1]); }
        } else if (pn < 8) {
            const bool isk = pn >= 6; const int pp = (pn - 4) & 1;
#pragma unroll
            for (int ai = 0; ai < 2; ++ai)
#pragma unroll
                for (int m = 0; m < 4; ++m) { const int rl = ai * 128 + wr * 64 + m * 16 + fr, grow = pm * 256 + rl, t = tq + rl;
#pragma unroll
                    for (int bj = 0; bj < 2; ++bj) { f32x4 v0 = acc[ai][bj][m][0], v1 = acc[ai][bj][m][1];
                        if (samp) rope8(v0, v1, t, wc, fq, rc, rs);
                        const int col = pp * 256 + bj * 128 + wc * 32 + 8 * fq;
                        if (!isk) { *(v4u*)(Q0 + (size_t)grow * 512 + col) = pack8(v0 * 0.125f, v1 * 0.125f); }
                        else { const int krow = samp ? 8192 + sb * 1280 + t : grow;
                            *(v4u*)(K0 + (size_t)krow * 512 + col) = pack8(v0, v1);
                            if (!samp) { float* o = out + O_NK0 + (size_t)grow * 512 + col; *(f32x4*)o = v0; *(f32x4*)(o + 4) = v1; } } } }
        } else {
            const int pp = pn - 8;
#pragma unroll
            for (int ai = 0; ai < 2; ++ai)
#pragma unroll
                for (int m = 0; m < 4; ++m) { const int rl = ai * 128 + wr * 64 + m * 16 + fr, grow = pm * 256 + rl, t = tq + rl;
#pragma unroll
                    for (int bj = 0; bj < 2; ++bj) { const f32x4 v0 = acc[ai][bj][m][0], v1 = acc[ai][bj][m][1];
                        const int col = pp * 256 + bj * 128 + wc * 32 + 8 * fq, h = pp * 2 + bj, dv0 = wc * 32 + 8 * fq;
                        if (!samp) { float* o = out + O_NV0 + (size_t)grow * 512 + col; *(f32x4*)o = v0; *(f32x4*)(o + 4) = v1; }
                        bf16* vb = samp ? VTS + ((size_t)((sb * 4 + h) * 128 + dv0)) * 1280 + t : VTP + ((size_t)((pm * 4 + h) * 128 + dv0)) * 256 + rl;
                        const int ks = samp ? 1280 : 256;
#pragma unroll
                        for (int e = 0; e < 4; ++e) { vb[(size_t)e * ks] = (bf16)f2bf(v0[e]); vb[(size_t)(e + 4) * ks] = (bf16)f2bf(v1[e]); } } }
        }
    }
};
struct EpiQkv1 {
    static constexpr bool PERM = true, AFTER_DRAIN = false;
    bf16 *Q1, *K1, *VTP, *VTS; float* out; const float *rc, *rs;
    __device__ __forceinline__ void operator()(const f32x4 (&acc)[2][2][4][2], const Unit& u, int wr, int wc, int fr_in, int fq_in) const {
        int fr = fr_in, fq = fq_in; asm volatile("" : "+v"(fr), "+v"(fq));
        const int pn = u.pn, pm = u.pm; const bool samp = pm >= 32;
        const int sb = (pm - 32) >> 2, tq = ((pm - 32) & 3) * 256;
        if (pn < 4) {
#pragma unroll
            for (int ai = 0; ai < 2; ++ai)
#pragma unroll
                for (int m = 0; m < 4; ++m) { const int rl = ai * 128 + wr * 64 + m * 16 + fr, grow = pm * 256 + rl, t = tq + rl;
#pragma unroll
                    for (int bj = 0; bj < 2; ++bj) { f32x4 v0 = acc[ai][bj][m][0], v1 = acc[ai][bj][m][1];
                        if (samp) rope8(v0, v1, t, wc, fq, rc, rs);
                        *(v4u*)(Q1 + (size_t)grow * 1024 + pn * 256 + bj * 128 + wc * 32 + 8 * fq) = pack8(v0 * 0.125f, v1 * 0.125f); } }
        } else if (pn == 4) {
#pragma unroll
            for (int ai = 0; ai < 2; ++ai)
#pragma unroll
                for (int m = 0; m < 4; ++m) { const int rl = ai * 128 + wr * 64 + m * 16 + fr, grow = pm * 256 + rl, t = tq + rl;
#pragma unroll
                    for (int bj = 0; bj < 2; ++bj) { f32x4 v0 = acc[ai][bj][m][0], v1 = acc[ai][bj][m][1];
                        const int cl = bj * 128 + wc * 32 + 8 * fq;
                        if (samp) rope8(v0, v1, t, wc, fq, rc, rs);
                        const int krow = samp ? 8192 + sb * 1280 + t : grow;
                        *(v4u*)(K1 + (size_t)krow * 256 + cl) = pack8(v0, v1);
                        if (!samp) { float* o = out + O_NK1 + (size_t)grow * 256 + cl; *(f32x4*)o = v0; *(f32x4*)(o + 4) = v1; } } }
        } else {
#pragma unroll
            for (int ai = 0; ai < 2; ++ai)
#pragma unroll
                for (int m = 0; m < 4; ++m) { const int rl = ai * 128 + wr * 64 + m * 16 + fr, grow = pm * 256 + rl, t = tq + rl;
#pragma unroll
                    for (int bj = 0; bj < 2; ++bj) { const f32x4 v0 = acc[ai][bj][m][0], v1 = acc[ai][bj][m][1];
                        const int cl = bj * 128 + wc * 32 + 8 * fq, hk = bj * 2 + (wc >> 1), d0 = (wc & 1) * 32 + 8 * fq;
                        if (!samp) { float* o = out + O_NV1 + (size_t)grow * 256 + cl; *(f32x4*)o = v0; *(f32x4*)(o + 4) = v1; }
                        bf16* vb = samp ? VTS + ((size_t)((sb * 4 + hk) * 64 + d0)) * 1280 + t : VTP + ((size_t)((pm * 4 + hk) * 64 + d0)) * 256 + rl;
                        const int ks = samp ? 1280 : 256;
#pragma unroll
                        for (int e = 0; e < 4; ++e) { vb[(size_t)e * ks] = (bf16)f2bf(v0[e]); vb[(size_t)(e + 4) * ks] = (bf16)f2bf(v1[e]); } } }
        }
    }
};

template <int NJ, int DV>
__device__ __forceinline__ void attn_unit(LAS unsigned char* lds, int tid_in, const bf16* Qp, int ldq, const bf16* Kp, int ldk, const bf16* Vt, int ldv,
                                          int a0, int na, int b0, int nb, bool maskB, int qpos0, float lam, const float* subg, float sink, bf16* Op, int ldo) {
    constexpr int KB = NJ * 9216, BUFB = KB + DV * 144, NVC = DV / 64, NDT = DV / 16;
    int tid = tid_in; asm volatile("" : "+v"(tid));
    const int lane = tid & 63, wave = tid >> 6, fr = lane & 15, fq = lane >> 4;
    bf16x8 qf[NJ][2];
#pragma unroll
    for (int j = 0; j < NJ; ++j)
#pragma unroll
        for (int ks = 0; ks < 2; ++ks) qf[j][ks] = *(const bf16x8*)(Qp + (size_t)(wave * 16 + fr) * ldq + j * 64 + ks * 32 + fq * 8);
    f32x4 O[NJ][NDT]; float mrun[NJ], lrun[NJ];
#pragma unroll
    for (int j = 0; j < NJ; ++j) { mrun[j] = -1e30f; lrun[j] = 0.f;
#pragma unroll
        for (int dt = 0; dt < NDT; ++dt) O[j][dt] = (f32x4){0.f, 0.f, 0.f, 0.f}; }
    const int ntiles = na + nb;
    v4u kr[NJ], vr[NVC];
    { const int ks0 = (na > 0) ? a0 : b0;
#pragma unroll
      for (int i = 0; i < NJ; ++i) { const int c = tid + i * 512, key = c / (8 * NJ), part = c % (8 * NJ); kr[i] = *(const v4u*)(Kp + (size_t)(ks0 + key) * ldk + part * 8); }
#pragma unroll
      for (int i = 0; i < NVC; ++i) { const int c = tid + i * 512, dv = c >> 3, kc = c & 7; vr[i] = *(const v4u*)(Vt + (size_t)dv * ldv + ks0 + kc * 8); }
#pragma unroll
      for (int i = 0; i < NJ; ++i) { const int c = tid + i * 512, key = c / (8 * NJ), part = c % (8 * NJ), j = part >> 3, dch = part & 7; *(LAS v4u*)(lds + ((j * 64 + key) * 72 + dch * 8) * 2) = kr[i]; }
#pragma unroll
      for (int i = 0; i < NVC; ++i) { const int c = tid + i * 512, dv = c >> 3, kc = c & 7; *(LAS v4u*)(lds + KB + (dv * 72 + kc * 8) * 2) = vr[i]; }
    }
    __syncthreads();
    for (int it = 0; it < ntiles; ++it) {
        const int kstart = (it < na) ? a0 + 64 * it : b0 + 64 * (it - na);
        const bool more = it + 1 < ntiles;
        if (more) { const int ks1 = (it + 1 < na) ? a0 + 64 * (it + 1) : b0 + 64 * (it + 1 - na);
#pragma unroll
            for (int i = 0; i < NJ; ++i) { const int c = tid + i * 512, key = c / (8 * NJ), part = c % (8 * NJ); kr[i] = *(const v4u*)(Kp + (size_t)(ks1 + key) * ldk + part * 8); }
#pragma unroll
            for (int i = 0; i < NVC; ++i) { const int c = tid + i * 512, dv = c >> 3, kc = c & 7; vr[i] = *(const v4u*)(Vt + (size_t)dv * ldv + ks1 + kc * 8); } }
        const bool masked = maskB && it >= na;
        const int qw = qpos0 + wave * 16;
        const bool skip = masked && (kstart > qw + 15 + 128 || kstart + 63 < qw - 128);
        if (!skip) {
            LAS unsigned char* kb = lds + (it & 1) * BUFB;
            f32x4 s[NJ][4];
#pragma unroll
            for (int j = 0; j < NJ; ++j)
#pragma unroll
                for (int kt = 0; kt < 4; ++kt) { s[j][kt] = (f32x4){0.f, 0.f, 0.f, 0.f};
#pragma unroll
                    for (int ks = 0; ks < 2; ++ks) { const bf16x8 kf = *(const LAS bf16x8*)(kb + ((j * 64 + kt * 16 + fr) * 72 + ks * 32 + fq * 8) * 2);
                        s[j][kt] = __builtin_amdgcn_mfma_f32_16x16x32_bf16(kf, qf[j][ks], s[j][kt], 0, 0, 0); } }
            if (masked) { const int qp = qw + fr;
#pragma unroll
                for (int j = 0; j < NJ; ++j)
#pragma unroll
                    for (int kt = 0; kt < 4; ++kt)
#pragma unroll
                        for (int e = 0; e < 4; ++e) { const int dlt = qp - (kstart + kt * 16 + fq * 4 + e); if (dlt > 128 || dlt < -128) s[j][kt][e] = -1e30f; } }
            bf16x8 pf[NJ][2];
#pragma unroll
            for (int j = 0; j < NJ; ++j) {
                float mx = -1e30f;
#pragma unroll
                for (int kt = 0; kt < 4; ++kt) mx = fmaxf(mx, fmaxf(fmaxf(s[j][kt][0], s[j][kt][1]), fmaxf(s[j][kt][2], s[j][kt][3])));
                mx = fmaxf(mx, __shfl_xor(mx, 16)); mx = fmaxf(mx, __shfl_xor(mx, 32));
                const float mnew = fmaxf(mrun[j], mx), alpha = __builtin_amdgcn_exp2f((mrun[j] - mnew) * LOG2E), mb = mnew * LOG2E;
                mrun[j] = mnew; float ps = 0.f;
#pragma unroll
                for (int kt = 0; kt < 4; ++kt)
#pragma unroll
                    for (int e = 0; e < 4; ++e) { const float p = __builtin_amdgcn_exp2f(s[j][kt][e] * LOG2E - mb); s[j][kt][e] = p; ps += p; }
                lrun[j] = lrun[j] * alpha + ps;
#pragma unroll
                for (int dt = 0; dt < NDT; ++dt) O[j][dt] = O[j][dt] * alpha;
#pragma unroll
                for (int kk = 0; kk < 2; ++kk) { const v4u w = pack8(s[j][2 * kk], s[j][2 * kk + 1]); pf[j][kk] = __builtin_bit_cast(bf16x8, w); }
            }
            LAS unsigned char* vb = kb + KB;
#pragma unroll
            for (int dt = 0; dt < NDT; ++dt)
#pragma unroll
                for (int kk = 0; kk < 2; ++kk) {
                    const v2u lo = *(const LAS v2u*)(vb + ((dt * 16 + fr) * 72 + kk * 32 + fq * 4) * 2), hi = *(const LAS v2u*)(vb + ((dt * 16 + fr) * 72 + kk * 32 + 16 + fq * 4) * 2);
                    const v4u w = {lo.x, lo.y, hi.x, hi.y}; const bf16x8 vf = __builtin_bit_cast(bf16x8, w);
#pragma unroll
                    for (int j = 0; j < NJ; ++j) O[j][dt] = __builtin_amdgcn_mfma_f32_16x16x32_bf16(vf, pf[j][kk], O[j][dt], 0, 0, 0);
                }
        }
        if (more) { LAS unsigned char* nb_ = lds + ((it + 1) & 1) * BUFB;
#pragma unroll
            for (int i = 0; i < NJ; ++i) { const int c = tid + i * 512, key = c / (8 * NJ), part = c % (8 * NJ), j = part >> 3, dch = part & 7; *(LAS v4u*)(nb_ + ((j * 64 + key) * 72 + dch * 8) * 2) = kr[i]; }
#pragma unroll
            for (int i = 0; i < NVC; ++i) { const int c = tid + i * 512, dv = c >> 3, kc = c & 7; *(LAS v4u*)(nb_ + KB + (dv * 72 + kc * 8) * 2) = vr[i]; } }
        __syncthreads();
    }
    float linv[NJ];
#pragma unroll
    for (int j = 0; j < NJ; ++j) { float l = lrun[j]; l += __shfl_xor(l, 16); l += __shfl_xor(l, 32);
        if (NJ == 1) l += __builtin_amdgcn_exp2f((sink - mrun[j]) * LOG2E);
        linv[j] = 1.f / l; }
    bf16* orow = Op + (size_t)(wave * 16 + fr) * ldo + fq * 4;
    if constexpr (NJ == 2) {
        const float i0 = linv[0], i1 = lam * linv[1]; float ss = 0.f;
#pragma unroll
        for (int dt = 0; dt < NDT; ++dt) { O[0][dt] = O[0][dt] * i0 - O[1][dt] * i1;
#pragma unroll
            for (int e = 0; e < 4; ++e) ss += O[0][dt][e] * O[0][dt][e]; }
        ss += __shfl_xor(ss, 16); ss += __shfl_xor(ss, 32);
        const float r = rsqrtf(ss * (1.f / DV) + EPS) * 0.8f;
#pragma unroll
        for (int dt = 0; dt < NDT; ++dt) { const f32x4 g = *(const f32x4*)(subg + dt * 16 + fq * 4); const f32x4 o = O[0][dt] * g * r;
            v2u w; w.x = cvt_pk_bf16(o[0], o[1]); w.y = cvt_pk_bf16(o[2], o[3]); *(v2u*)(orow + dt * 16) = w; }
    } else {
#pragma unroll
        for (int dt = 0; dt < NDT; ++dt) { const f32x4 o = O[0][dt] * linv[0]; v2u w; w.x = cvt_pk_bf16(o[0], o[1]); w.y = cvt_pk_bf16(o[2], o[3]); *(v2u*)(orow + dt * 16) = w; }
    }
}

__device__ __forceinline__ void conv_unit(LAS unsigned char* lds, int tid_in, int unit, const bf16* Z, const float* cw, const float* cb, const float* lg, const float* lb, bf16* CAT) {
    asm volatile("" ::: "memory");
    int tid = tid_in; asm volatile("" : "+v"(tid));
    const int row0 = unit * 32;
    int seq0, slen; if (row0 < MP) { seq0 = row0 & ~255; slen = 256; } else { seq0 = MP + ((row0 - MP) & ~1023); slen = 1024; }
    LAS unsigned char* zt = lds;
    LAS float* co = (LAS float*)(lds + 63488);
#pragma unroll 1
    for (int c = tid; c < 62 * 64; c += 512) { const int r = c >> 6, cc = c & 63, tok = row0 - 15 + r;
        v4u v = {0u, 0u, 0u, 0u}; if (tok >= seq0 && tok < seq0 + slen) v = *(const v4u*)(Z + (size_t)tok * 512 + cc * 8);
        *(LAS v4u*)(zt + r * 1024 + cc * 16) = v; }
    __syncthreads();
    { const int cp = tid & 255, half = tid >> 8;
      float wx[31], wy[31];
#pragma unroll
      for (int w = 0; w < 31; ++w) { const pg8::f32x2 t2 = *(const pg8::f32x2*)(cw + w * 512 + 2 * cp); wx[w] = t2.x; wy[w] = t2.y; }
      const pg8::f32x2 bb = *(const pg8::f32x2*)(cb + 2 * cp);
#pragma unroll 1
      for (int t = 0; t < 16; ++t) { const int tl = half * 16 + t; float ax = bb.x, ay = bb.y;
#pragma unroll
          for (int w = 0; w < 31; ++w) { const unsigned zz = *(const LAS unsigned*)(zt + (tl + w) * 1024 + cp * 4); ax += bflo(zz) * wx[w]; ay += bfhi(zz) * wy[w]; }
          *(LAS pg8::f32x2*)(co + tl * 512 + 2 * cp) = (pg8::f32x2){ax, ay}; } }
    __syncthreads();
    { const int lane = tid & 63, wave = tid >> 6;
      const f32x4 g0 = *(const f32x4*)(lg + lane * 8), g1 = *(const f32x4*)(lg + lane * 8 + 4), b0 = *(const f32x4*)(lb + lane * 8), b1 = *(const f32x4*)(lb + lane * 8 + 4);
#pragma unroll 1
      for (int t = 0; t < 4; ++t) { const int tl = wave * 4 + t;
          f32x4 x0 = *(const LAS f32x4*)(co + tl * 512 + lane * 8), x1 = *(const LAS f32x4*)(co + tl * 512 + lane * 8 + 4);
          const float mu = wave_sum((x0[0] + x0[1]) + (x0[2] + x0[3]) + (x1[0] + x1[1]) + (x1[2] + x1[3])) * (1.f / 512.f);
          x0 = x0 - mu; x1 = x1 - mu;
          const float var = wave_sum((x0[0] * x0[0] + x0[1] * x0[1]) + (x0[2] * x0[2] + x0[3] * x0[3]) + (x1[0] * x1[0] + x1[1] * x1[1]) + (x1[2] * x1[2] + x1[3] * x1[3])) * (1.f / 512.f);
          const float rs = rsqrtf(var + EPS);
          x0 = x0 * rs * g0 + b0; x1 = x1 * rs * g1 + b1;
#pragma unroll
          for (int e = 0; e < 4; ++e) { x0[e] = x0[e] * fsigmoid(x0[e]); x1[e] = x1[e] * fsigmoid(x1[e]); }
          *(v4u*)(CAT + (size_t)(row0 + tl) * 1024 + lane * 8) = pack8(x0, x1); } }
    __syncthreads();
}

__device__ __forceinline__ void rowwise_phase(int gw, int NGW, int lane, const float* xp, const float* xs, const bf16* br, const float* ngA, const float* gate,
                                              float* xout, const float* ngB, const float* mod2, int sc_off, int sh_off, bf16* H) {
    for (int row = gw; row < MT; row += NGW) {
        const int cond = row < MP ? 2 : (row - MP) >> 10;
        const float* xr = row < MP ? xp + (size_t)row * D : xs + (size_t)(row - MP) * D;
        f32x4 x[4];
#pragma unroll
        for (int j = 0; j < 4; ++j) x[j] = *(const f32x4*)(xr + lane * 4 + 256 * j);
        if (br) {
            f32x4 b[4]; float ss = 0.f;
#pragma unroll
            for (int j = 0; j < 4; ++j) { const v2u w = *(const v2u*)(br + (size_t)row * D + lane * 4 + 256 * j); b[j] = (f32x4){bflo(w.x), bfhi(w.x), bflo(w.y), bfhi(w.y)};
                ss += (b[j][0] * b[j][0] + b[j][1] * b[j][1]) + (b[j][2] * b[j][2] + b[j][3] * b[j][3]); }
            const float r = rsqrtf(wave_sum(ss) * (1.f / D) + EPS);
#pragma unroll
            for (int j = 0; j < 4; ++j) { const int col = lane * 4 + 256 * j; const f32x4 g = *(const f32x4*)(gate + cond * 6144 + col), na = *(const f32x4*)(ngA + col);
                x[j] = x[j] + g * (b[j] * r * na); *(f32x4*)(xout + (size_t)row * D + col) = x[j]; }
        }
        if (H) {
            float ss = 0.f;
#pragma unroll
            for (int j = 0; j < 4; ++j) ss += (x[j][0] * x[j][0] + x[j][1] * x[j][1]) + (x[j][2] * x[j][2] + x[j][3] * x[j][3]);
            const float r = rsqrtf(wave_sum(ss) * (1.f / D) + EPS);
#pragma unroll
            for (int j = 0; j < 4; ++j) { const int col = lane * 4 + 256 * j; const f32x4 nb = *(const f32x4*)(ngB + col), sc = *(const f32x4*)(mod2 + cond * 6144 + sc_off + col), sh = *(const f32x4*)(mod2 + cond * 6144 + sh_off + col);
                const f32x4 h = x[j] * r * nb * (sc + 1.f) + sh; v2u w; w.x = cvt_pk_bf16(h[0], h[1]); w.y = cvt_pk_bf16(h[2], h[3]); *(v2u*)(H + (size_t)row * D + col) = w; }
        }
    }
}

__device__ __forceinline__ void p0_transpose_item(const float* W, int K, int N, bf16* WT, int mode, LAS float* scr, int item, int lane) {
    const int nblk = N / 32, kb = item / nblk, nb = item % nblk, k0 = 64 * kb, n0 = 32 * nb;
    int d0 = n0;
    if (mode == 1) { if (n0 < 512) d0 = 256 * (n0 >> 7) + (n0 & 127); else if (n0 < 1024) { const int c = n0 - 512; d0 = 256 * (c >> 7) + 128 + (c & 127); } }
    else if (mode == 2) { if (n0 < FH) d0 = 256 * (n0 >> 7) + (n0 & 127); else { const int c = n0 - FH; d0 = 256 * (c >> 7) + 128 + (c & 127); } }
#pragma unroll 8
    for (int i = 0; i < 32; ++i) { const int kk = 2 * i + (lane >> 5); scr[kk * 33 + (lane & 31)] = W[(size_t)(k0 + kk) * N + n0 + (lane & 31)]; }
    asm volatile("s_waitcnt lgkmcnt(0)" ::: "memory");
    const int c = lane & 7;
#pragma unroll
    for (int j = 0; j < 4; ++j) { const int n = (lane >> 3) + 8 * j; const LAS float* s = scr + (8 * c) * 33 + n;
        v4u o; o.x = pk2(s[0 * 33], s[1 * 33]); o.y = pk2(s[2 * 33], s[3 * 33]); o.z = pk2(s[4 * 33], s[5 * 33]); o.w = pk2(s[6 * 33], s[7 * 33]);
        *(v4u*)(WT + (size_t)(d0 + n) * K + k0 + 8 * c) = o; }
    asm volatile("s_waitcnt lgkmcnt(0)" ::: "memory");
}
__device__ __forceinline__ float fsilu(float x) { return x / (1.f + expf(-x)); }

__device__ __forceinline__ void prep_phase(const Args& a, LAS unsigned char* lds, int gw, int NGW, int wave, int lane) {
    unsigned char* ws = a.ws;
    LAS float* scr = (LAS float*)(lds + wave * 16384);
    constexpr int T0 = 1280, T1 = T0 + 512, T2 = T1 + 2816, T3 = T2 + 1408, T4 = T3 + 768, T5 = T4 + 512, T6 = T5 + 2816, T7 = T6 + 1408;
    constexpr int G_END = T7 + 3072, K0C = G_END + 512, K1C = K0C + 512, V0C = K1C + 256, V1C = V0C + 128, RP = V1C + 16, TOTAL = RP + 1;
    for (int it = gw; it < TOTAL; it += NGW) {
        if (it < T7) {
            if (it < T0) p0_transpose_item(a.in[11], 1024, NIN0, (bf16*)(ws + WS_WIN0), 1, scr, it, lane);
            else if (it < T1) p0_transpose_item(a.in[18], 1024, 1024, (bf16*)(ws + WS_WOUT0), 0, scr, it - T0, lane);
            else if (it < T2) p0_transpose_item(a.in[19], 1024, NGU, (bf16*)(ws + WS_WGU0), 2, scr, it - T1, lane);
            else if (it < T3) p0_transpose_item(a.in[20], FH, 1024, (bf16*)(ws + WS_WDN0), 0, scr, it - T2, lane);
            else if (it < T4) p0_transpose_item(a.in[24], 1024, NQKV1, (bf16*)(ws + WS_WQKV1), 0, scr, it - T3, lane);
            else if (it < T5) p0_transpose_item(a.in[26], 1024, 1024, (bf16*)(ws + WS_WOUT1), 0, scr, it - T4, lane);
            else if (it < T6) p0_transpose_item(a.in[27], 1024, NGU, (bf16*)(ws + WS_WGU1), 2, scr, it - T5, lane);
            else p0_transpose_item(a.in[28], FH, 1024, (bf16*)(ws + WS_WDN1), 0, scr, it - T6, lane);
        } else if (it < G_END) {
            const int r = it - T7, layer = r / 1536, q = r % 1536, strip = q % 24, kc = q / 24, k0 = kc * 16;
            const float* W = a.in[layer ? 21 : 8]; const float* bias = a.in[layer ? 22 : 9];
            const float* c = a.in[6]; const float* cx = a.in[7];
            const int col = strip * 256 + lane * 4;
            f32x4 a0 = {0.f, 0.f, 0.f, 0.f}, a1 = a0, a2 = a0;
#pragma unroll 4
            for (int rr = 0; rr < 16; ++rr) { const int k = k0 + rr; const f32x4 w = *(const f32x4*)(W + (size_t)k * 6144 + col);
                a0 = a0 + w * fsilu(c[k]); a1 = a1 + w * fsilu(c[1024 + k]); a2 = a2 + w * fsilu(cx[k]); }
            if (kc == 0) { const f32x4 b = *(const f32x4*)(bias + col); a0 = a0 + b; a1 = a1 + b; a2 = a2 + b; }
            float* m = (float*)(ws + WS_MOD) + layer * 3 * 6144 + col;
#pragma unroll
            for (int e = 0; e < 4; ++e) { unsafeAtomicAdd(m + e, a0[e]); unsafeAtomicAdd(m + 6144 + e, a1[e]); unsafeAtomicAdd(m + 2 * 6144 + e, a2[e]); }
        } else if (it < K0C) {
            const int r = it - G_END, b = r >> 8, t = r & 255; const float* s = a.in[2] + (size_t)r * 512 + lane * 8;
            const f32x4 v0 = *(const f32x4*)s, v1 = *(const f32x4*)(s + 4);
            *(v4u*)((bf16*)(ws + WS_K0) + (size_t)(MP + b * 1280 + 1024 + t) * 512 + lane * 8) = pack8(v0, v1);
        } else if (it < K1C) {
            const int r = it - K0C, b = r >> 8, t = r & 255; const f32x4 v0 = *(const f32x4*)(a.in[4] + (size_t)r * 256 + lane * 4);
            v2u w; w.x = cvt_pk_bf16(v0[0], v0[1]); w.y = cvt_pk_bf16(v0[2], v0[3]);
            *(v2u*)((bf16*)(ws + WS_K1) + (size_t)(MP + b * 1280 + 1024 + t) * 256 + lane * 4) = w;
        } else if (it < V0C) {
            const int r = it - K1C, dvb = r & 7, h = (r >> 3) & 3, tb = (r >> 5) & 3, b = r >> 7;
            const float* s = a.in[3] + ((size_t)(b * 256 + tb * 64 + lane) * 4 + h) * 128 + dvb * 16;
            bf16* d = (bf16*)(ws + WS_VT0S) + ((size_t)((b * 4 + h) * 128 + dvb * 16)) * 1280 + 1024 + tb * 64 + lane;
#pragma unroll
            for (int q = 0; q < 4; ++q) { const f32x4 v = *(const f32x4*)(s + 4 * q);
#pragma unroll
                for (int e = 0; e < 4; ++e) d[(size_t)(4 * q + e) * 1280] = (bf16)f2bf(v[e]); }
        } else if (it < V1C) {
            const int r = it - V0C, db = r & 3, h = (r >> 2) & 3, tb = (r >> 4) & 3, b = r >> 6;
            const float* s = a.in[5] + ((size_t)(b * 256 + tb * 64 + lane) * 4 + h) * 64 + db * 16;
            bf16* d = (bf16*)(ws + WS_VT1S) + ((size_t)((b * 4 + h) * 64 + db * 16)) * 1280 + 1024 + tb * 64 + lane;
#pragma unroll
            for (int q = 0; q < 4; ++q) { const f32x4 v = *(const f32x4*)(s + 4 * q);
#pragma unroll
                for (int e = 0; e < 4; ++e) d[(size_t)(4 * q + e) * 1280] = (bf16)f2bf(v[e]); }
        } else if (it < RP) {
            const int e = (it - V1C) * 64 + lane, pos = e >> 4, i = e & 15;
            const float inv = 1.0f / powf(10000.0f, (float)(2 * i) / 32.0f), ang = (float)pos * inv;
            ((float*)(ws + WS_ROPEC))[e] = cosf(ang); ((float*)(ws + WS_ROPES))[e] = sinf(ang);
        } else {
            const float* lf = a.in[16];
            const float s1 = wave_sum(lf[lane] * lf[64 + lane]), s2 = wave_sum(lf[128 + lane] * lf[192 + lane]);
            if (lane == 0) *(float*)(ws + WS_LAM) = expf(s1) - expf(s2) + 0.2f;
        }
    }
}

#define XB_TMO      128
#define XB_XCNT(j)  (256  + 64 * (j))
#define XB_XSUB(j)  (1280 + 64 * (j))
#define XB_XGEN(j)  (2304 + 64 * (j))
#define XB_TOP      3328
#define XB_TOPGEN   3392
#define XCD_BAR_WORDS 3456
#define XB_SPIN_CAP (1u << 18)

__device__ __forceinline__ unsigned xb_ld(unsigned* p)              { return __hip_atomic_load(p, __ATOMIC_RELAXED, __HIP_MEMORY_SCOPE_AGENT); }
__device__ __forceinline__ unsigned xb_add(unsigned* p, unsigned v) { return __hip_atomic_fetch_add(p, v, __ATOMIC_RELAXED, __HIP_MEMORY_SCOPE_AGENT); }
__device__ __forceinline__ unsigned xb_xcc_id() { return (unsigned)__builtin_amdgcn_s_getreg((3 << 11) | 20) & 0xFu; }
#define XB_SPIN(cond, bar) do { unsigned _sp = 0; while (cond) { __builtin_amdgcn_s_sleep(1); \
    if ((++_sp & 255u) == 0u) { if (xb_ld(&(bar)[XB_TMO])) break; if (_sp > XB_SPIN_CAP) { atomicAdd(&(bar)[XB_TMO], 1u); break; } } } } while (0)

struct XcdBarrier {
    unsigned* bar; unsigned x;
    volatile LAS unsigned* st;
};

__device__ __forceinline__ XcdBarrier xcd_barrier_post(unsigned* bar, volatile LAS unsigned* st) {
    XcdBarrier b; b.bar = bar; b.x = xb_xcc_id(); b.st = st;
    if (threadIdx.x == 0) (void)xb_add(&bar[XB_XCNT(b.x)], 1u);
    return b;
}
__device__ __forceinline__ void xcd_barrier_complete(unsigned* bar, unsigned x, unsigned& nloc, unsigned& nx) {
    const unsigned G = gridDim.x * gridDim.y * gridDim.z;
    unsigned sum, cnt, mine, sp = 0u;
    for (;;) {
        sum = 0u; cnt = 0u; mine = 0u;
#pragma unroll
        for (unsigned j = 0; j < 16; ++j) { const unsigned c = xb_ld(&bar[XB_XCNT(j)]); sum += c; cnt += (c > 0u) ? 1u : 0u; mine = (j == x) ? c : mine; }
        if (sum == G) break;
        __builtin_amdgcn_s_sleep(1);
        if ((++sp & 255u) == 0u) { if (xb_ld(&bar[XB_TMO])) break; if (sp > XB_SPIN_CAP) { atomicAdd(&bar[XB_TMO], 1u); break; } }
    }
    nloc = mine > 0u ? mine : 1u; nx = cnt > 0u ? cnt : 1u;
}

__device__ __forceinline__ void xcd_barrier(const XcdBarrier& b) {
    asm volatile("s_waitcnt vmcnt(0)" ::: "memory");
    __syncthreads();
    if (threadIdx.x == 0) {
        unsigned* bar = b.bar;
        __builtin_amdgcn_s_waitcnt(0);
        unsigned nloc = b.st[0], nx = b.st[1];
        if (nloc == 0u) { xcd_barrier_complete(bar, b.x, nloc, nx); b.st[0] = nloc; b.st[1] = nx; }
        const unsigned old = xb_add(&bar[XB_XSUB(b.x)], 1u);
        const unsigned gen = old / nloc;
        if (old + 1u == (gen + 1u) * nloc) {
            __builtin_amdgcn_fence(__ATOMIC_RELEASE, "agent");
            asm volatile("s_waitcnt vmcnt(0)" ::: "memory");
            const unsigned og = xb_add(&bar[XB_TOP], 1u);
            const unsigned tg = og / nx;
            if (og + 1u == (tg + 1u) * nx) xb_add(&bar[XB_TOPGEN], 1u);
            else XB_SPIN(xb_ld(&bar[XB_TOPGEN]) == tg, bar);
            __builtin_amdgcn_fence(__ATOMIC_ACQUIRE, "agent");
            xb_add(&bar[XB_XGEN(b.x)], 1u);
            asm volatile("s_waitcnt vmcnt(0)" ::: "memory");
        } else {
            XB_SPIN(xb_ld(&bar[XB_XGEN(b.x)]) == gen, bar);
            __builtin_amdgcn_fence(__ATOMIC_ACQUIRE, "agent");
            asm volatile("s_waitcnt vmcnt(0)" ::: "memory");
        }
    }
    __syncthreads();
}

__global__ void __launch_bounds__(512, 2) mega_fwd(Args a) {
    extern __shared__ __attribute__((aligned(16))) unsigned char lds_raw[];
    LAS unsigned char* lds = (LAS unsigned char*)lds_raw;
    cg::grid_group grid = cg::this_grid();
    const int tid = threadIdx.x, lane = tid & 63, wave = __builtin_amdgcn_readfirstlane(tid >> 6);
    const int G = gridDim.x, bx = blockIdx.x, gw = bx * 8 + wave, NGW = G * 8;
    unsigned char* ws = a.ws; float* out = a.out;
    const float* mod0 = (const float*)(ws + WS_MOD); const float* mod1 = mod0 + 3 * 6144;
    bf16* Hb = (bf16*)(ws + WS_H); bf16* CAT = (bf16*)(ws + WS_CAT); bf16* MIX = (bf16*)(ws + WS_MIX); bf16* ACT = (bf16*)(ws + WS_ACT);
    const float* rc = (const float*)(ws + WS_ROPEC); const float* rs = (const float*)(ws + WS_ROPES);
    float* Y = out + O_Y;
    const int lo = a.ph_lo, hi = a.ph_hi;
    volatile LAS unsigned* xst = (volatile LAS unsigned*)(lds + 131072 + 512);
    if (tid < 64) ((LAS unsigned*)(lds + 131072))[tid + 96] = 0u;
    __syncthreads();
    XcdBarrier bar; bar.bar = (unsigned*)(ws + WS_BAR); bar.x = 0; bar.st = nullptr;
    if (hi - lo > 1) { bar = xcd_barrier_post((unsigned*)(ws + WS_BAR), xst); grid.sync(); }
#ifndef MK_NOCONV
#define MK_NOCONV 0
#endif
#ifndef MK_NOATT0
#define MK_NOATT0 0
#endif
#ifndef MK_PHMASK
#define MK_PHMASK 0xffffu
#endif
#define IN(k) (((MK_PHMASK >> (k)) & 1u) && lo <= (k) && (k) < hi)
#ifndef MK_XSYNC
#define MK_XSYNC 0
#endif
#ifndef MK_DUP
#define MK_DUP 0u
#endif
#define PH(k) if (IN(k)) for (int rep_ = 0; rep_ <= (int)((MK_DUP >> (k)) & 1u); ++rep_)
#define RSYNC do { if (rep_) xcd_barrier(bar); } while (0)
#define SEAM(k) do { if (IN(k) && IN((k) + 1)) xcd_barrier(bar); } while (0)
#define GEMM(EpiT, E, Ap, Bp, Nn, Kk) do { pg8::Gemm g{(const pg8::bf16_t*)(Ap), (const pg8::bf16_t*)(Bp), MT, (Nn), (Kk)}; pg8::StaticOrder S; S.init(MT, (Nn), G, bx); \
        pg8::gemm_phase<EpiT, pg8::StaticOrder, true, true>(lds, g, S, E); } while (0)

    PH(0) { RSYNC; prep_phase(a, lds, gw, NGW, wave, lane); }
    SEAM(0);
    for (int xs_ = 0; xs_ < MK_XSYNC; ++xs_) xcd_barrier(bar);
    PH(1) { RSYNC; rowwise_phase(gw, NGW, lane, a.in[0], a.in[1], nullptr, nullptr, nullptr, nullptr, a.in[10], mod0, 1024, 0, Hb); }
    SEAM(1);
    PH(2) { RSYNC; EpiIn0 E{(bf16*)(ws + WS_Z), (bf16*)(ws + WS_Q0), (bf16*)(ws + WS_K0), (bf16*)(ws + WS_VT0P), (bf16*)(ws + WS_VT0S), out, rc, rs};
        GEMM(EpiIn0, E, Hb, ws + WS_WIN0, NIN0, 1024); }
    SEAM(2);
    PH(3) { RSYNC;
        const float lam = __hip_atomic_load((const float*)(ws + WS_LAM), __ATOMIC_RELAXED, __HIP_MEMORY_SCOPE_AGENT);
        const bf16* Q0 = (const bf16*)(ws + WS_Q0); const bf16* K0 = (const bf16*)(ws + WS_K0);
        const bool split = G >= 128;
        int u = bx, stride = G;
        if (split && bx >= 64) { u = 64 + (bx - 64); stride = G - 64; }
        for (; u < 640; u += stride) {
            if (u < 320 && !MK_NOATT0) { int row0, krow0, ldv, nt; const bf16* vt; int b, h;
                if (u < 64) { const int bh = u & 7, qb = u >> 3; b = bh >> 2; h = bh & 3; row0 = MP + b * 1024 + qb * 128; krow0 = MP + b * 1280; ldv = 1280; nt = 20; vt = (const bf16*)(ws + WS_VT0S); }
                else { const int p = u - 64, qb = p & 1, bh = p >> 1; b = bh >> 2; h = bh & 3; row0 = b * 256 + qb * 128; krow0 = b * 256; ldv = 256; nt = 4; vt = (const bf16*)(ws + WS_VT0P); }
                attn_unit<2, 128>(lds, tid, Q0 + (size_t)row0 * 512 + h * 128, 512, K0 + (size_t)krow0 * 512 + h * 128, 512,
                                  vt + (size_t)(b * 4 + h) * 128 * ldv, ldv, 0, nt, 0, 0, false, 0, lam, a.in[17], 0.f, CAT + (size_t)row0 * 1024 + 512 + h * 128, 1024);
                if (split && u < 64) break;
            } else if (!MK_NOCONV) conv_unit(lds, tid, u - 320, (const bf16*)(ws + WS_Z), a.in[12], a.in[13], a.in[14], a.in[15], CAT);
        }
    }
    SEAM(3);
    PH(4) { RSYNC; EpiStore E{MIX, 1024}; GEMM(EpiStore, E, CAT, ws + WS_WOUT0, 1024, 1024); }
    SEAM(4);
    PH(5) { RSYNC; rowwise_phase(gw, NGW, lane, a.in[0], a.in[1], MIX, a.in[10] + 1024, mod0 + 2048, Y, a.in[10] + 2048, mod0, 4096, 3072, Hb); }
    SEAM(5);
    PH(6) { RSYNC; EpiSwiglu E{ACT}; GEMM(EpiSwiglu, E, Hb, ws + WS_WGU0, NGU, 1024); }
    SEAM(6);
    PH(7) { RSYNC; EpiStore E{MIX, 1024}; GEMM(EpiStore, E, ACT, ws + WS_WDN0, 1024, FH); }
    SEAM(7);
    PH(8) { RSYNC; rowwise_phase(gw, NGW, lane, Y, Y + (size_t)MP * D, MIX, a.in[10] + 3072, mod0 + 5120, Y, a.in[23], mod1, 1024, 0, Hb); }
    SEAM(8);
    PH(9) { RSYNC; EpiQkv1 E{(bf16*)(ws + WS_Q1), (bf16*)(ws + WS_K1), (bf16*)(ws + WS_VT1P), (bf16*)(ws + WS_VT1S), out, rc, rs};
        GEMM(EpiQkv1, E, Hb, ws + WS_WQKV1, NQKV1, 1024); }
    SEAM(9);
    PH(10) { RSYNC;
        const bf16* Q1 = (const bf16*)(ws + WS_Q1); const bf16* K1 = (const bf16*)(ws + WS_K1);
        for (int u = bx; u < 1280; u += G) {
            int row0, krow0, ldv, b0, nb, qpos0, qh, bq; const bf16* vt; bool mk;
            if (u < 256) { const int qb = u >> 5, rest = u & 31; bq = rest >> 4; qh = rest & 15; row0 = MP + bq * 1024 + qb * 128; krow0 = MP + bq * 1280; ldv = 1280; vt = (const bf16*)(ws + WS_VT1S);
                const int wlo = (qb * 128 - 128) < 0 ? 0 : qb * 128 - 128, whi = (qb * 128 + 256) > 1024 ? 1024 : qb * 128 + 256; b0 = wlo; nb = (whi - wlo) / 64; qpos0 = qb * 128; mk = true; }
            else { const int p = u - 256, qb = p & 1, rest = p >> 1; qh = rest & 15; bq = rest >> 4; row0 = bq * 256 + qb * 128; krow0 = bq * 256; ldv = 256; vt = (const bf16*)(ws + WS_VT1P); b0 = 0; nb = 0; qpos0 = 0; mk = false; }
            const int hk = qh >> 2;
            attn_unit<1, 64>(lds, tid, Q1 + (size_t)row0 * 1024 + qh * 64, 1024, K1 + (size_t)krow0 * 256 + hk * 64, 256, vt + (size_t)(bq * 4 + hk) * 64 * ldv, ldv,
                             mk ? 1024 : 0, 4, b0, nb, mk, qpos0, 0.f, nullptr, a.in[25][qh], CAT + (size_t)row0 * 1024 + qh * 64, 1024);
        }
    }
    SEAM(10);
    PH(11) { RSYNC; EpiStore E{MIX, 1024}; GEMM(EpiStore, E, CAT, ws + WS_WOUT1, 1024, 1024); }
    SEAM(11);
    PH(12) { RSYNC; rowwise_phase(gw, NGW, lane, Y, Y + (size_t)MP * D, MIX, a.in[23] + 1024, mod1 + 2048, Y, a.in[23] + 2048, mod1, 4096, 3072, Hb); }
    SEAM(12);
    PH(13) { RSYNC; EpiSwiglu E{ACT}; GEMM(EpiSwiglu, E, Hb, ws + WS_WGU1, NGU, 1024); }
    SEAM(13);
    PH(14) { RSYNC; EpiStore E{MIX, 1024}; GEMM(EpiStore, E, ACT, ws + WS_WDN1, 1024, FH); }
    SEAM(14);
    PH(15) { RSYNC; rowwise_phase(gw, NGW, lane, Y, Y + (size_t)MP * D, MIX, a.in[23] + 3072, mod1 + 5120, Y, nullptr, nullptr, 0, 0, nullptr); }
#undef IN
#undef SEAM
#undef GEMM
}

extern "C" void kernel_launch(void* const* d_in, const int* in_sizes, int n_in, void* d_out, int out_size, void* d_ws, size_t ws_size, hipStream_t stream) {
    static int grid = 0;
    if (grid == 0) {
        if (n_in != 29 || ws_size < WS_END) { fprintf(stderr, "kernel_launch: unexpected n_in %d / ws %zu\n", n_in, ws_size); grid = -1; return; }
        int dev = 0, cus = 0, per_cu = 0;
        (void)hipGetDevice(&dev); (void)hipDeviceGetAttribute(&cus, hipDeviceAttributeMultiprocessorCount, dev);
        if (hipFuncSetAttribute((const void*)mega_fwd, hipFuncAttributeMaxDynamicSharedMemorySize, LDS_BYTES) != hipSuccess) { fprintf(stderr, "kernel_launch: hipFuncSetAttribute failed\n"); grid = -1; return; }
        if (hipOccupancyMaxActiveBlocksPerMultiprocessor(&per_cu, (const void*)mega_fwd, 512, LDS_BYTES) != hipSuccess || per_cu < 1) { fprintf(stderr, "kernel_launch: occupancy query says %d\n", per_cu); per_cu = 1; }
        (void)hipGetLastError();
        if (cus <= 0) cus = 256;
        grid = cus * (per_cu > 1 ? 1 : per_cu);
    }
    if (grid < 0) return;
    (void)hipMemsetAsync((char*)d_ws, 0, WS_ZERO_BYTES, stream);
    Args a{};
    for (int i = 0; i < 29; ++i) a.in[i] = (const float*)d_in[i];
    a.out = (float*)d_out; a.ws = (unsigned char*)d_ws;
#if MK_PER_PHASE
    for (int p = 0; p < NPH; ++p) { a.ph_lo = p; a.ph_hi = p + 1; hipLaunchKernelGGL(mega_fwd, dim3(grid), dim3(512), LDS_BYTES, stream, a); }
#else
    a.ph_lo = 0; a.ph_hi = NPH;
    void* args[] = {&a};
    hipError_t e = hipLaunchCooperativeKernel((const void*)mega_fwd, dim3(grid), dim3(512), args, LDS_BYTES, stream);
    if (e != hipSuccess) fprintf(stderr, "kernel_launch: cooperative launch failed: %s (grid %d)\n", hipGetErrorString(e), grid);
#endif
}
```

```cpp
#include <hip/hip_runtime.h>
#include <hip/hip_cooperative_groups.h>
#include <cstdio>
#include <cstdint>
namespace cg = cooperative_groups;

namespace pg8 {
#define PG8_LAS __attribute__((address_space(3)))
typedef unsigned short bf16_t;
typedef short bf16x8 __attribute__((ext_vector_type(8)));
typedef float f32x4 __attribute__((ext_vector_type(4)));
typedef unsigned u32x4 __attribute__((ext_vector_type(4)));
constexpr int BM = 256, BK = 64, HALF = 128, HTB = HALF * BK * 2  , STAGE_BYTES = 8 * HTB, NXCD = 8, WGM = 8;

__host__ __device__ __forceinline__ int lds_byte(int r, int c) { const int st = (r >> 4) * 2 + (c >> 5), rr = r & 15, cc = c & 31, ob = rr * 64 + cc * 2; return st * 1024 + (ob ^ (((ob >> 9) & 1) << 5)); }
__host__ __device__ __forceinline__ void stage_rc(int b, int& R, int& C) { const int st = b / 1024, sb = b % 1024, swz = sb ^ (((sb >> 9) & 1) << 5); R = (st >> 1) * 16 + swz / 64; C = (st & 1) * 32 + (swz % 64) / 2; }
__host__ __device__ __forceinline__ int perm32(int rho) { const int n = rho >> 4, i = rho & 15; return 8 * (i >> 2) + 4 * n + (i & 3); }

struct Unit { int pm, pn; };
struct Gemm { const bf16_t* A; const bf16_t* Bt; int M, N, K; };

struct StaticOrder {
    int nM, nN, nwg, G, c;
    __host__ __device__ void init(int M, int N, int G_, int c_) { nM = M / BM; nN = N / BM; nwg = nM * nN; G = G_; c = c_; }
    __host__ __device__ bool next(int i, Unit& u) const {
        const long L = (long)i * G + c; if (L >= nwg) return false;
        int wgid = (int)L; { const int q = nwg / NXCD, r = nwg % NXCD, xcd = wgid % NXCD, off = wgid / NXCD; wgid = (xcd < r ? xcd * (q + 1) : r * (q + 1) + (xcd - r) * q) + off; }
        const int nig = WGM * nN, gid = wgid / nig, fm = gid * WGM, gsz = (nM - fm) < WGM ? (nM - fm) : WGM;
        u.pm = fm + ((wgid % nig) % gsz); u.pn = (wgid % nig) / gsz; return true;
    }
    __device__ __forceinline__ void a_ready(const Unit&) const {}
    __device__ __forceinline__ void done(const Unit&) const {}
};

__device__ __forceinline__ unsigned cvt_pk_bf16(float lo, float hi) { unsigned r; asm volatile("v_cvt_pk_bf16_f32 %0, %1, %2" : "=v"(r) : "v"(lo), "v"(hi)); return r; }
typedef float f32x2 __attribute__((ext_vector_type(2)));
template <class Epi, class Sched, bool ALIGN_EPI = false, bool SP2 = false>
__device__ __forceinline__ void gemm_phase(PG8_LAS unsigned char* lds, const Gemm g, const Sched& S, const Epi& E) {
    const int tid = threadIdx.x, wid = __builtin_amdgcn_readfirstlane(tid >> 6), lane = tid & 63, wr = wid >> 2, wc = wid & 3, fr = lane & 15, fq = lane >> 4;
    const int K = g.K, nt = K / BK;
    unsigned voffA[2], voffB[2];
#pragma unroll
    for (int i = 0; i < 2; ++i) { int R, C; stage_rc(tid * 16 + i * 8192, R, C); const int Rb = Epi::PERM ? ((R & ~31) + perm32(R & 31)) : R;
        voffA[i] = (unsigned)(R * K + C) * 2u; voffB[i] = (unsigned)(Rb * K + C) * 2u; }
    const size_t kstep = (size_t)(BK * 2);
    const size_t hstep = (size_t)HALF * K * 2;
    const size_t tstep = 2 * hstep;
    const unsigned ldsw = (unsigned)wid * 1024u;
    const int aoff = lds_byte(wr * 64 + fr, fq * 8), boff = lds_byte(wc * 32 + fr, fq * 8);
#define PG8_SA(b, h) (((b) * 2 + (h)) * HTB)
#define PG8_SB(b, h) ((4 + (b) * 2 + (h)) * HTB)
#define PG8_STAGE(bufoff, gbase, voff) do { _Pragma("unroll") for (int _i = 0; _i < 2; ++_i) \
        __builtin_amdgcn_global_load_lds((const unsigned*)((const char*)(gbase) + (voff)[_i]), (PG8_LAS unsigned*)(lds + (bufoff) + ldsw + _i * 8192), 16, 0, 0); } while (0)
#define PG8_LDA(dst, b, h) do { _Pragma("unroll") for (int m = 0; m < 4; ++m) _Pragma("unroll") for (int k = 0; k < 2; ++k) dst[m][k] = *(const PG8_LAS bf16x8*)(lds + PG8_SA(b, h) + aoff + m * 2048 + k * 1024); } while (0)
#define PG8_LDB(dst, b, h) do { _Pragma("unroll") for (int n = 0; n < 2; ++n) _Pragma("unroll") for (int k = 0; k < 2; ++k) dst[n][k] = *(const PG8_LAS bf16x8*)(lds + PG8_SB(b, h) + boff + n * 2048 + k * 1024); } while (0)
#define PG8_MMA(ai, bj, At, Bt) do { __builtin_amdgcn_s_setprio(1); _Pragma("unroll") for (int m = 0; m < 4; ++m) _Pragma("unroll") for (int n = 0; n < 2; ++n) _Pragma("unroll") for (int k = 0; k < 2; ++k) \
        acc[ai][bj][m][n] = __builtin_amdgcn_mfma_f32_16x16x32_bf16(Bt[n][k], At[m][k], acc[ai][bj][m][n], 0, 0, 0); __builtin_amdgcn_s_setprio(0); } while (0)
#define PG8_WAIT_V(n) asm volatile("s_waitcnt vmcnt(" #n ")" ::: "memory")
#define PG8_WAIT_L(n) asm volatile("s_waitcnt lgkmcnt(" #n ")" ::: "memory")
#define PG8_BAR __builtin_amdgcn_s_barrier()
#define PG8_SCHED __builtin_amdgcn_sched_barrier(0)
    Unit cur, nxt; int ui = 0;
    if (!S.next(0, cur)) return;
    f32x4 acc[2][2][4][2];
#pragma unroll
    for (int a = 0; a < 2; ++a)
#pragma unroll
        for (int b = 0; b < 2; ++b)
#pragma unroll
            for (int m = 0; m < 4; ++m)
#pragma unroll
                for (int n = 0; n < 2; ++n) acc[a][b][m][n] = (f32x4){0.f, 0.f, 0.f, 0.f};
    bf16x8 At[4][2], B0[2][2], B1[2][2];
    const char* cA = (const char*)g.A + (size_t)cur.pm * tstep; const char* cB = (const char*)g.Bt + (size_t)cur.pn * tstep;
    S.a_ready(cur);
    if constexpr (SP2) {
        PG8_STAGE(PG8_SB(0, 0), cB, voffB); PG8_STAGE(PG8_SB(0, 1), cB + hstep, voffB); PG8_STAGE(PG8_SA(0, 0), cA, voffA); PG8_STAGE(PG8_SA(0, 1), cA + hstep, voffA);
        if (wr == 1) PG8_BAR;
        PG8_WAIT_V(2); PG8_BAR;
        PG8_STAGE(PG8_SB(1, 0), cB + kstep, voffB); PG8_STAGE(PG8_SA(1, 0), cA + kstep, voffA); PG8_STAGE(PG8_SB(1, 1), cB + hstep + kstep, voffB);
        PG8_WAIT_V(6); PG8_BAR;
    } else {
        PG8_STAGE(PG8_SB(0, 0), cB, voffB); PG8_STAGE(PG8_SA(0, 0), cA, voffA); PG8_STAGE(PG8_SB(0, 1), cB + hstep, voffB); PG8_STAGE(PG8_SA(0, 1), cA + hstep, voffA);
        if (wr == 1) PG8_BAR;
        PG8_WAIT_V(4); PG8_BAR;
        PG8_STAGE(PG8_SB(1, 0), cB + kstep, voffB); PG8_STAGE(PG8_SA(1, 0), cA + kstep, voffA); PG8_STAGE(PG8_SB(1, 1), cB + hstep + kstep, voffB);
        PG8_WAIT_V(6); PG8_BAR;
    }
    for (;;) {
        const bool has_next = S.next(ui + 1, nxt);
        const char* nA = has_next ? (const char*)g.A + (size_t)nxt.pm * tstep : cA; const char* nB = has_next ? (const char*)g.Bt + (size_t)nxt.pn * tstep : cB;
        for (int t = 0; t < nt; t += 2) {
            const bool last = (t == nt - 2);
            const char* a1 = cA + (size_t)(t + 1) * kstep;
            const char* a2 = last ? nA : cA + (size_t)(t + 2) * kstep; const char* b2 = last ? nB : cB + (size_t)(t + 2) * kstep;
            const char* a3 = a2 + kstep; const char* b3 = b2 + kstep;
            if (last && has_next) S.a_ready(nxt);
            if constexpr (SP2) {
            PG8_LDB(B0, 0, 0); PG8_LDB(B1, 0, 1); PG8_SCHED; PG8_LDA(At, 0, 0); PG8_STAGE(PG8_SA(1, 1), a1 + hstep, voffA);
            PG8_WAIT_V(8); PG8_WAIT_L(0); PG8_BAR; PG8_MMA(0, 0, At, B0); PG8_MMA(0, 1, At, B1); PG8_BAR; PG8_SCHED;
            PG8_LDA(At, 0, 1); PG8_STAGE(PG8_SB(0, 0), b2, voffB); PG8_STAGE(PG8_SB(0, 1), b2 + hstep, voffB); PG8_STAGE(PG8_SA(0, 0), a2, voffA);
            PG8_WAIT_V(8); PG8_WAIT_L(0); PG8_BAR; PG8_MMA(1, 0, At, B0); PG8_MMA(1, 1, At, B1); PG8_BAR; PG8_SCHED;
            PG8_LDB(B0, 1, 0); PG8_LDB(B1, 1, 1); PG8_SCHED; PG8_LDA(At, 1, 0); PG8_STAGE(PG8_SA(0, 1), a2 + hstep, voffA);
            PG8_WAIT_V(8); PG8_WAIT_L(0); PG8_BAR; PG8_MMA(0, 0, At, B0); PG8_MMA(0, 1, At, B1); PG8_BAR; PG8_SCHED;
            PG8_LDA(At, 1, 1); PG8_STAGE(PG8_SB(1, 0), b3, voffB); PG8_STAGE(PG8_SB(1, 1), b3 + hstep, voffB); PG8_STAGE(PG8_SA(1, 0), a3, voffA);
            PG8_WAIT_V(8); PG8_WAIT_L(0); PG8_BAR; PG8_MMA(1, 0, At, B0); PG8_MMA(1, 1, At, B1); PG8_BAR; PG8_SCHED;
            } else {
            PG8_LDB(B0, 0, 0); PG8_SCHED; PG8_LDA(At, 0, 0); PG8_STAGE(PG8_SA(1, 1), a1 + hstep, voffA);
            PG8_WAIT_L(8); PG8_BAR; PG8_WAIT_L(0); PG8_MMA(0, 0, At, B0); PG8_BAR; PG8_SCHED;
            PG8_LDB(B1, 0, 1); PG8_STAGE(PG8_SB(0, 0), b2, voffB);
            PG8_BAR; PG8_WAIT_L(0); PG8_MMA(0, 1, At, B1); PG8_BAR;
            PG8_LDA(At, 0, 1); PG8_STAGE(PG8_SA(0, 0), a2, voffA);
            PG8_BAR; PG8_WAIT_L(0); PG8_MMA(1, 0, At, B0); PG8_BAR; PG8_SCHED;
            PG8_STAGE(PG8_SB(0, 1), b2 + hstep, voffB);
            PG8_WAIT_V(6); PG8_BAR; PG8_MMA(1, 1, At, B1); PG8_BAR;
            PG8_LDB(B0, 1, 0); PG8_SCHED; PG8_LDA(At, 1, 0); PG8_STAGE(PG8_SA(0, 1), a2 + hstep, voffA);
            PG8_WAIT_L(8); PG8_BAR; PG8_WAIT_L(0); PG8_MMA(0, 0, At, B0); PG8_BAR; PG8_SCHED;
            PG8_LDB(B1, 1, 1); PG8_STAGE(PG8_SB(1, 0), b3, voffB);
            PG8_BAR; PG8_WAIT_L(0); PG8_MMA(0, 1, At, B1); PG8_BAR;
            PG8_LDA(At, 1, 1); PG8_STAGE(PG8_SA(1, 0), a3, voffA);
            PG8_BAR; PG8_WAIT_L(0); PG8_MMA(1, 0, At, B0); PG8_BAR; PG8_SCHED;
            PG8_STAGE(PG8_SB(1, 1), b3 + hstep, voffB);
            PG8_WAIT_V(6); PG8_BAR; PG8_MMA(1, 1, At, B1); PG8_BAR;
            }
        }
        if constexpr (ALIGN_EPI) { if (wr == 0) PG8_BAR; }
        if constexpr (!Epi::AFTER_DRAIN) { E(acc, cur, wr, wc, fr, fq); S.done(cur); }
        if (!has_next) break;
#pragma unroll
        for (int a = 0; a < 2; ++a)
#pragma unroll
            for (int b = 0; b < 2; ++b)
#pragma unroll
                for (int m = 0; m < 4; ++m)
#pragma unroll
                    for (int n = 0; n < 2; ++n) acc[a][b][m][n] = (f32x4){0.f, 0.f, 0.f, 0.f};
        cur = nxt; cA = nA; cB = nB; ++ui;
        if constexpr (ALIGN_EPI) { if (wr == 1) PG8_BAR; }
    }
    PG8_WAIT_V(0);
    if constexpr (!ALIGN_EPI) { if (wr == 0) PG8_BAR; }
    PG8_BAR;
    if constexpr (Epi::AFTER_DRAIN) { E.fused(acc, cur, wr, wc, fr, fq, lds, wid, lane); S.done(cur); }
#undef PG8_SA
#undef PG8_SB
#undef PG8_STAGE
#undef PG8_LDA
#undef PG8_LDB
#undef PG8_MMA
#undef PG8_WAIT_V
#undef PG8_WAIT_L
#undef PG8_BAR
#undef PG8_SCHED
}
}

#ifndef MK_PER_PHASE
#define MK_PER_PHASE 0
#endif
#define GAS __attribute__((address_space(1)))
#define LAS __attribute__((address_space(3)))
typedef unsigned short bf16;
typedef unsigned v4u __attribute__((ext_vector_type(4)));
typedef unsigned v2u __attribute__((ext_vector_type(2)));
using pg8::f32x4; using pg8::bf16x8; using pg8::Unit; using pg8::cvt_pk_bf16;

constexpr int D = 1024, MP = 8192, MS = 2048, MT = 10240;
constexpr int NIN0 = 2560, NQKV1 = 1536, FH = 2816, NGU = 5632;
constexpr float EPS = 1e-6f, LOG2E = 1.4426950408889634f;
constexpr int NPH = 16;
constexpr size_t O_Y = 0, O_NK0 = 10485760, O_NV0 = 14680064, O_NK1 = 18874368, O_NV1 = 20971520;
constexpr size_t MiB = 1u << 20;
constexpr size_t WS_MOD = 0;
constexpr size_t WS_BAR = 524288, WS_ZERO_BYTES = 614400;
constexpr size_t WS_LAM = 262144;
constexpr size_t WS_ROPEC = 327680, WS_ROPES = 327680 + 4096;
constexpr size_t WS_WIN0 = 1 * MiB, WS_WOUT0 = 6 * MiB, WS_WGU0 = 8 * MiB, WS_WDN0 = 19 * MiB;
constexpr size_t WS_WQKV1 = 25 * MiB, WS_WOUT1 = 28 * MiB, WS_WGU1 = 30 * MiB, WS_WDN1 = 41 * MiB;
constexpr size_t WS_H = 47 * MiB, WS_Z = 67 * MiB, WS_Q0 = 77 * MiB, WS_Q1 = 67 * MiB;
constexpr size_t WS_K0 = 87 * MiB, WS_VT0P = 98 * MiB, WS_VT0S = 106 * MiB;
constexpr size_t WS_CAT = 109 * MiB, WS_MIX = 129 * MiB, WS_ACT = 149 * MiB;
constexpr size_t WS_K1 = 204 * MiB, WS_VT1P = 210 * MiB, WS_VT1S = 214 * MiB, WS_END = 216 * MiB;
constexpr int LDS_BYTES = 147456;

struct Args { const float* in[29]; float* out; unsigned char* ws; int ph_lo, ph_hi; };

__device__ __forceinline__ unsigned f2bf(float f) { unsigned u = __builtin_bit_cast(unsigned, f); return (u + 0x7fffu + ((u >> 16) & 1u)) >> 16; }
__device__ __forceinline__ unsigned pk2(float lo, float hi) { return f2bf(lo) | (f2bf(hi) << 16); }
__device__ __forceinline__ float bflo(unsigned w) { return __builtin_bit_cast(float, w << 16); }
__device__ __forceinline__ float bfhi(unsigned w) { return __builtin_bit_cast(float, w & 0xffff0000u); }
__device__ __forceinline__ v4u pack8(f32x4 a, f32x4 b) { v4u w; w.x = cvt_pk_bf16(a[0], a[1]); w.y = cvt_pk_bf16(a[2], a[3]); w.z = cvt_pk_bf16(b[0], b[1]); w.w = cvt_pk_bf16(b[2], b[3]); return w; }
__device__ __forceinline__ float fsigmoid(float x) { return __builtin_amdgcn_rcpf(1.f + __expf(-x)); }
__device__ __forceinline__ float wave_sum(float v) {
#pragma unroll
    for (int o = 1; o < 64; o <<= 1) v += __shfl_xor(v, o);
    return v;
}

struct EpiStore {
    static constexpr bool PERM = true, AFTER_DRAIN = false;
    bf16* O; int ldc;
    __device__ __forceinline__ void operator()(const f32x4 (&acc)[2][2][4][2], const Unit& u, int wr, int wc, int fr_in, int fq_in) const {
        int fr = fr_in, fq = fq_in; asm volatile("" : "+v"(fr), "+v"(fq));
        const int row0 = u.pm * 256 + wr * 64 + fr, col0 = u.pn * 256 + wc * 32 + 8 * fq;
#pragma unroll
        for (int ai = 0; ai < 2; ++ai)
#pragma unroll
            for (int m = 0; m < 4; ++m) { bf16* rowp = O + (size_t)(row0 + ai * 128 + m * 16) * ldc + col0;
#pragma unroll
                for (int bj = 0; bj < 2; ++bj) *(v4u*)(rowp + bj * 128) = pack8(acc[ai][bj][m][0], acc[ai][bj][m][1]); }
    }
};
struct EpiSwiglu {
    static constexpr bool PERM = true, AFTER_DRAIN = false;
    bf16* O;
    __device__ __forceinline__ void operator()(const f32x4 (&acc)[2][2][4][2], const Unit& u, int wr, int wc, int fr_in, int fq_in) const {
        int fr = fr_in, fq = fq_in; asm volatile("" : "+v"(fr), "+v"(fq));
        const int row0 = u.pm * 256 + wr * 64 + fr, col0 = u.pn * 128 + wc * 32 + 8 * fq;
#pragma unroll
        for (int ai = 0; ai < 2; ++ai)
#pragma unroll
            for (int m = 0; m < 4; ++m) {
                f32x4 r[2];
#pragma unroll
                for (int n = 0; n < 2; ++n)
#pragma unroll
                    for (int e = 0; e < 4; ++e) { const float g = acc[ai][0][m][n][e]; r[n][e] = g * fsigmoid(g) * acc[ai][1][m][n][e]; }
                *(v4u*)(O + (size_t)(row0 + ai * 128 + m * 16) * FH + col0) = pack8(r[0], r[1]); }
    }
};
__device__ __forceinline__ void rope4(f32x4& v, int i0, float sg, const float* rc, const float* rs) {
    const f32x4 c = *(const f32x4*)(rc + i0), s = *(const f32x4*)(rs + i0);
    f32x4 p;
#pragma unroll
    for (int e = 0; e < 4; ++e) p[e] = __shfl_xor(v[e], 32);
    v = v * c + (p * s) * sg;
}
__device__ __forceinline__ void rope8(f32x4& v0, f32x4& v1, int t, int wc, int fq, const float* rc, const float* rs) {
    const int pos = (wc & 1) ? (t & 63) : (t >> 6);
    const int i0 = pos * 16 + 8 * (fq & 1);
    const float sg = (fq & 2) ? 1.f : -1.f;
    rope4(v0, i0, sg, rc, rs); rope4(v1, i0 + 4, sg, rc, rs);
}
struct EpiIn0 {
    static constexpr bool PERM = true, AFTER_DRAIN = false;
    bf16 *Z, *Q0, *K0, *VTP, *VTS; float* out; const float *rc, *rs;
    __device__ __forceinline__ void operator()(const f32x4 (&acc)[2][2][4][2], const Unit& u, int wr, int wc, int fr_in, int fq_in) const {
        int fr = fr_in, fq = fq_in; asm volatile("" : "+v"(fr), "+v"(fq));
        const int pn = u.pn, pm = u.pm; const bool samp = pm >= 32;
        const int sb = (pm - 32) >> 2, tq = ((pm - 32) & 3) * 256;
        if (pn < 4) {
            const int col0 = pn * 128 + wc * 32 + 8 * fq;
#pragma unroll
            for (int ai = 0; ai < 2; ++ai)
#pragma unroll
                for (int m = 0; m < 4; ++m) { const int grow = pm * 256 + ai * 128 + wr * 64 + m * 16 + fr;
                    f32x4 r[2];
#pragma unroll
                    for (int n = 0; n < 2; ++n)
#pragma unroll
                        for (int e = 0; e < 4; ++e) r[n][e] = acc[ai][0][m][n][e] * fsigmoid(acc[ai][1][m][n][e]);
                    *(v4u*)(Z + (size_t)grow * 512 + col0) = pack8(r[0], r[1]); }
        } else if (pn < 8) {
            const bool isk = pn >= 6; const int pp = (pn - 4) & 1;
#pragma unroll
            for (int ai = 0; ai < 2; ++ai)
#pragma unroll
                for (int m = 0; m < 4; ++m) { const int rl = ai * 128 + wr * 64 + m * 16 + fr, grow = pm * 256 + rl, t = tq + rl;
#pragma unroll
                    for (int bj = 0; bj < 2; ++bj) { f32x4 v0 = acc[ai][bj][m][0], v1 = acc[ai][bj][m][1];
                        if (samp) rope8(v0, v1, t, wc, fq, rc, rs);
                        const int col = pp * 256 + bj * 128 + wc * 32 + 8 * fq;
                        if (!isk) { *(v4u*)(Q0 + (size_t)grow * 512 + col) = pack8(v0 * 0.125f, v1 * 0.125f); }
                        else { const int krow = samp ? 8192 + sb * 1280 + t : grow;
                            *(v4u*)(K0 + (size_t)krow * 512 + col) = pack8(v0, v1);
                            if (!samp) { float* o = out + O_NK0 + (size_t)grow * 512 + col; *(f32x4*)o = v0; *(f32x4*)(o + 4) = v1; } } } }
        } else {
            const int pp = pn - 8;
#pragma unroll
            for (int ai = 0; ai < 2; ++ai)
#pragma unroll
                for (int m = 0; m < 4; ++m) { const int rl = ai * 128 + wr * 64 + m * 16 + fr, grow = pm * 256 + rl, t = tq + rl;
#pragma unroll
                    for (int bj = 0; bj < 2; ++bj) { const f32x4 v0 = acc[ai][bj][m][0], v1 = acc[ai][bj][m][1];
                        const int col = pp * 256 + bj * 128 + wc * 32 + 8 * fq, h = pp * 2 + bj, dv0 = wc * 32 + 8 * fq;
                        if (!samp) { float* o = out + O_NV0 + (size_t)grow * 512 + col; *(f32x4*)o = v0; *(f32x4*)(o + 4) = v1; }
                        bf16* vb = samp ? VTS + ((size_t)((sb * 4 + h) * 128 + dv0)) * 1280 + t : VTP + ((size_t)((pm * 4 + h) * 128 + dv0)) * 256 + rl;
                        const int ks = samp ? 1280 : 256;
#pragma unroll
                        for (int e = 0; e < 4; ++e) { vb[(size_t)e * ks] = (bf16)f2bf(v0[e]); vb[(size_t)(e + 4) * ks] = (bf16)f2bf(v1[e]); } } }
        }
    }
};
struct EpiQkv1 {
    static constexpr bool PERM = true, AFTER_DRAIN = false;
    bf16 *Q1, *K1, *VTP, *VTS; float* out; const float *rc, *rs;
    __device__ __forceinline__ void operator()(const f32x4 (&acc)[2][2][4][2], const Unit& u, int wr, int wc, int fr_in, int fq_in) const {
        int fr = fr_in, fq = fq_in; asm volatile("" : "+v"(fr), "+v"(fq));
        const int pn = u.pn, pm = u.pm; const bool samp = pm >= 32;
        const int sb = (pm - 32) >> 2, tq = ((pm - 32) & 3) * 256;
        if (pn < 4) {
#pragma unroll
            for (int ai = 0; ai < 2; ++ai)
#pragma unroll
                for (int m = 0; m < 4; ++m) { const int rl = ai * 128 + wr * 64 + m * 16 + fr, grow = pm * 256 + rl, t = tq + rl;
#pragma unroll
                    for (int bj = 0; bj < 2; ++bj) { f32x4 v0 = acc[ai][bj][m][0], v1 = acc[ai][bj][m][1];
                        if (samp) rope8(v0, v1, t, wc, fq, rc, rs);
                        *(v4u*)(Q1 + (size_t)grow * 1024 + pn * 256 + bj * 128 + wc * 32 + 8 * fq) = pack8(v0 * 0.125f, v1 * 0.125f); } }
        } else if (pn == 4) {
#pragma unroll
            for (int ai = 0; ai < 2; ++ai)
#pragma unroll
                for (int m = 0; m < 4; ++m) { const int rl = ai * 128 + wr * 64 + m * 16 + fr, grow = pm * 256 + rl, t = tq + rl;
#pragma unroll
                    for (int bj = 0; bj < 2; ++bj) { f32x4 v0 = acc[ai][bj][m][0], v1 = acc[ai][bj][m][1];
                        const int cl = bj * 128 + wc * 32 + 8 * fq;
                        if (samp) rope8(v0, v1, t, wc, fq, rc, rs);
                        const int krow = samp ? 8192 + sb * 1280 + t : grow;
                        *(v4u*)(K1 + (size_t)krow * 256 + cl) = pack8(v0, v1);
                        if (!samp) { float* o = out + O_NK1 + (size_t)grow * 256 + cl; *(f32x4*)o = v0; *(f32x4*)(o + 4) = v1; } } }
        } else {
#pragma unroll
            for (int ai = 0; ai < 2; ++ai)
#pragma unroll
                for (int m = 0; m < 4; ++m) { const int rl = ai * 128 + wr * 64 + m * 16 + fr, grow = pm * 256 + rl, t = tq + rl;
#pragma unroll
                    for (int bj = 0; bj < 2; ++bj) { const f32x4 v0 = acc[ai][bj][m][0], v1 = acc[ai][bj][m][1];
                        const int cl = bj * 128 + wc * 32 + 8 * fq, hk = bj * 2 + (wc >> 1), d0 = (wc & 1) * 32 + 8 * fq;
                        if (!samp) { float* o = out + O_NV1 + (size_t)grow * 256 + cl; *(f32x4*)o = v0; *(f32x4*)(o + 4) = v1; }
                        bf16* vb = samp ? VTS + ((size_t)((sb * 4 + hk) * 64 + d0)) * 1280 + t : VTP + ((size_t)((pm * 4 + hk) * 64 + d0)) * 256 + rl;
                        const int ks = samp ? 1280 : 256;
#pragma unroll
                        for (int e = 0; e < 4; ++e) { vb[(size_t)e * ks] = (bf16)f2bf(v0[e]); vb[(size_t)(e + 4) * ks] = (bf16)f2bf(v1[e]); } } }
        }
    }
};

template <int NJ, int DV>
__device__ __forceinline__ void attn_unit(LAS unsigned char* lds, int tid_in, const bf16* Qp, int ldq, const bf16* Kp, int ldk, const bf16* Vt, int ldv,
                                          int a0, int na, int b0, int nb, bool maskB, int qpos0, float lam, const float* subg, float sink, bf16* Op, int ldo) {
    constexpr int KB = NJ * 9216, BUFB = KB + DV * 144, NVC = DV / 64, NDT = DV / 16;
    int tid = tid_in; asm volatile("" : "+v"(tid));
    const int lane = tid & 63, wave = tid >> 6, fr = lane & 15, fq = lane >> 4;
    bf16x8 qf[NJ][2];
#pragma unroll
    for (int j = 0; j < NJ; ++j)
#pragma unroll
        for (int ks = 0; ks < 2; ++ks) qf[j][ks] = *(const bf16x8*)(Qp + (size_t)(wave * 16 + fr) * ldq + j * 64 + ks * 32 + fq * 8);
    f32x4 O[NJ][NDT]; float mrun[NJ], lrun[NJ];
#pragma unroll
    for (int j = 0; j < NJ; ++j) { mrun[j] = -1e30f; lrun[j] = 0.f;
#pragma unroll
        for (int dt = 0; dt < NDT; ++dt) O[j][dt] = (f32x4){0.f, 0.f, 0.f, 0.f}; }
    const int ntiles = na + nb;
    v4u kr[NJ], vr[NVC];
    { const int ks0 = (na > 0) ? a0 : b0;
#pragma unroll
      for (int i = 0; i < NJ; ++i) { const int c = tid + i * 512, key = c / (8 * NJ), part = c % (8 * NJ); kr[i] = *(const v4u*)(Kp + (size_t)(ks0 + key) * ldk + part * 8); }
#pragma unroll
      for (int i = 0; i < NVC; ++i) { const int c = tid + i * 512, dv = c >> 3, kc = c & 7; vr[i] = *(const v4u*)(Vt + (size_t)dv * ldv + ks0 + kc * 8); }
#pragma unroll
      for (int i = 0; i < NJ; ++i) { const int c = tid + i * 512, key = c / (8 * NJ), part = c % (8 * NJ), j = part >> 3, dch = part & 7; *(LAS v4u*)(lds + ((j * 64 + key) * 72 + dch * 8) * 2) = kr[i]; }
#pragma unroll
      for (int i = 0; i < NVC; ++i) { const int c = tid + i * 512, dv = c >> 3, kc = c & 7; *(LAS v4u*)(lds + KB + (dv * 72 + kc * 8) * 2) = vr[i]; }
    }
    __syncthreads();
    for (int it = 0; it < ntiles; ++it) {
        const int kstart = (it < na) ? a0 + 64 * it : b0 + 64 * (it - na);
        const bool more = it + 1 < ntiles;
        if (more) { const int ks1 = (it + 1 < na) ? a0 + 64 * (it + 1) : b0 + 64 * (it + 1 - na);
#pragma unroll
            for (int i = 0; i < NJ; ++i) { const int c = tid + i * 512, key = c / (8 * NJ), part = c % (8 * NJ); kr[i] = *(const v4u*)(Kp + (size_t)(ks1 + key) * ldk + part * 8); }
#pragma unroll
            for (int i = 0; i < NVC; ++i) { const int c = tid + i * 512, dv = c >> 3, kc = c & 7; vr[i] = *(const v4u*)(Vt + (size_t)dv * ldv + ks1 + kc * 8); } }
        const bool masked = maskB && it >= na;
        const int qw = qpos0 + wave * 16;
        const bool skip = masked && (kstart > qw + 15 + 128 || kstart + 63 < qw - 128);
        if (!skip) {
            LAS unsigned char* kb = lds + (it & 1) * BUFB;
            f32x4 s[NJ][4];
#pragma unroll
            for (int j = 0; j < NJ; ++j)
#pragma unroll
                for (int kt = 0; kt < 4; ++kt) { s[j][kt] = (f32x4){0.f, 0.f, 0.f, 0.f};
#pragma unroll
                    for (int ks = 0; ks < 2; ++ks) { const bf16x8 kf = *(const LAS bf16x8*)(kb + ((j * 64 + kt * 16 + fr) * 72 + ks * 32 + fq * 8) * 2);
                        s[j][kt] = __builtin_amdgcn_mfma_f32_16x16x32_bf16(kf, qf[j][ks], s[j][kt], 0, 0, 0); } }
            if (masked) { const int qp = qw + fr;
#pragma unroll
                for (int j = 0; j < NJ; ++j)
#pragma unroll
                    for (int kt = 0; kt < 4; ++kt)
#pragma unroll
                        for (int e = 0; e < 4; ++e) { const int dlt = qp - (kstart + kt * 16 + fq * 4 + e); if (dlt > 128 || dlt < -128) s[j][kt][e] = -1e30f; } }
            bf16x8 pf[NJ][2];
#pragma unroll
            for (int j = 0; j < NJ; ++j) {
                float mx = -1e30f;
#pragma unroll
                for (int kt = 0; kt < 4; ++kt) mx = fmaxf(mx, fmaxf(fmaxf(s[j][kt][0], s[j][kt][1]), fmaxf(s[j][kt][2], s[j][kt][3])));
                mx = fmaxf(mx, __shfl_xor(mx, 16)); mx = fmaxf(mx, __shfl_xor(mx, 32));
                const float mnew = fmaxf(mrun[j], mx), alpha = __builtin_amdgcn_exp2f((mrun[j] - mnew) * LOG2E), mb = mnew * LOG2E;
                mrun[j] = mnew; float ps = 0.f;
#pragma unroll
                for (int kt = 0; kt < 4; ++kt)
#pragma unroll
                    for (int e = 0; e < 4; ++e) { const float p = __builtin_amdgcn_exp2f(s[j][kt][e] * LOG2E - mb); s[j][kt][e] = p; ps += p; }
                lrun[j] = lrun[j] * alpha + ps;
#pragma unroll
                for (int dt = 0; dt < NDT; ++dt) O[j][dt] = O[j][dt] * alpha;
#pragma unroll
                for (int kk = 0; kk < 2; ++kk) { const v4u w = pack8(s[j][2 * kk], s[j][2 * kk + 1]); pf[j][kk] = __builtin_bit_cast(bf16x8, w); }
            }
            LAS unsigned char* vb = kb + KB;
#pragma unroll
            for (int dt = 0; dt < NDT; ++dt)
#pragma unroll
                for (int kk = 0; kk < 2; ++kk) {
                    const v2u lo = *(const LAS v2u*)(vb + ((dt * 16 + fr) * 72 + kk * 32 + fq * 4) * 2), hi = *(const LAS v2u*)(vb + ((dt * 16 + fr) * 72 + kk * 32 + 16 + fq * 4) * 2);
                    const v4u w = {lo.x, lo.y, hi.x, hi.y}; const bf16x8 vf = __builtin_bit_cast(bf16x8, w);
#pragma unroll
                    for (int j = 0; j < NJ; ++j) O[j][dt] = __builtin_amdgcn_mfma_f32_16x16x32_bf16(vf, pf[j][kk], O[j][dt], 0, 0, 0);
                }
        }
        if (more) { LAS unsigned char* nb_ = lds + ((it + 1) & 1) * BUFB;
#pragma unroll
            for (int i = 0; i < NJ; ++i) { const int c = tid + i * 512, key = c / (8 * NJ), part = c % (8 * NJ), j = part >> 3, dch = part & 7; *(LAS v4u*)(nb_ + ((j * 64 + key) * 72 + dch * 8) * 2) = kr[i]; }
#pragma unroll
            for (int i = 0; i < NVC; ++i) { const int c = tid + i * 512, dv = c >> 3, kc = c & 7; *(LAS v4u*)(nb_ + KB + (dv * 72 + kc * 8) * 2) = vr[i]; } }
        __syncthreads();
    }
    float linv[NJ];
#pragma unroll
    for (int j = 0; j < NJ; ++j) { float l = lrun[j]; l += __shfl_xor(l, 16); l += __shfl_xor(l, 32);
        if (NJ == 1) l += __builtin_amdgcn_exp2f((sink - mrun[j]) * LOG2E);
        linv[j] = 1.f / l; }
    bf16* orow = Op + (size_t)(wave * 16 + fr) * ldo + fq * 4;
    if constexpr (NJ == 2) {
        const float i0 = linv[0], i1 = lam * linv[1]; float ss = 0.f;
#pragma unroll
        for (int dt = 0; dt < NDT; ++dt) { O[0][dt] = O[0][dt] * i0 - O[1][dt] * i1;
#pragma unroll
            for (int e = 0; e < 4; ++e) ss += O[0][dt][e] * O[0][dt][e]; }
        ss += __shfl_xor(ss, 16); ss += __shfl_xor(ss, 32);
        const float r = rsqrtf(ss * (1.f / DV) + EPS) * 0.8f;
#pragma unroll
        for (int dt = 0; dt < NDT; ++dt) { const f32x4 g = *(const f32x4*)(subg + dt * 16 + fq * 4); const f32x4 o = O[0][dt] * g * r;
            v2u w; w.x = cvt_pk_bf16(o[0], o[1]); w.y = cvt_pk_bf16(o[2], o[3]); *(v2u*)(orow + dt * 16) = w; }
    } else {
#pragma unroll
        for (int dt = 0; dt < NDT; ++dt) { const f32x4 o = O[0][dt] * linv[0]; v2u w; w.x = cvt_pk_bf16(o[0], o[1]); w.y = cvt_pk_bf16(o[2], o[3]); *(v2u*)(orow + dt * 16) = w; }
    }
}

__device__ __forceinline__ void conv_unit(LAS unsigned char* lds, int tid_in, int unit, const bf16* Z, const float* cw, const float* cb, const float* lg, const float* lb, bf16* CAT) {
    asm volatile("" ::: "memory");
    int tid = tid_in; asm volatile("" : "+v"(tid));
    const int row0 = unit * 32;
    int seq0, slen; if (row0 < MP) { seq0 = row0 & ~255; slen = 256; } else { seq0 = MP + ((row0 - MP) & ~1023); slen = 1024; }
    LAS unsigned char* zt = lds;
    LAS float* co = (LAS float*)(lds + 63488);
#pragma unroll 1
    for (int c = tid; c < 62 * 64; c += 512) { const int r = c >> 6, cc = c & 63, tok = row0 - 15 + r;
        v4u v = {0u, 0u, 0u, 0u}; if (tok >= seq0 && tok < seq0 + slen) v = *(const v4u*)(Z + (size_t)tok * 512 + cc * 8);
        *(LAS v4u*)(zt + r * 1024 + cc * 16) = v; }
    __syncthreads();
    { const int cp = tid & 255, half = tid >> 8;
      float wx[31], wy[31];
#pragma unroll
      for (int w = 0; w < 31; ++w) { const pg8::f32x2 t2 = *(const pg8::f32x2*)(cw + w * 512 + 2 * cp); wx[w] = t2.x; wy[w] = t2.y; }
      const pg8::f32x2 bb = *(const pg8::f32x2*)(cb + 2 * cp);
#pragma unroll 1
      for (int t = 0; t < 16; ++t) { const int tl = half * 16 + t; float ax = bb.x, ay = bb.y;
#pragma unroll
          for (int w = 0; w < 31; ++w) { const unsigned zz = *(const LAS unsigned*)(zt + (tl + w) * 1024 + cp * 4); ax += bflo(zz) * wx[w]; ay += bfhi(zz) * wy[w]; }
          *(LAS pg8::f32x2*)(co + tl * 512 + 2 * cp) = (pg8::f32x2){ax, ay}; } }
    __syncthreads();
    { const int lane = tid & 63, wave = tid >> 6;
      const f32x4 g0 = *(const f32x4*)(lg + lane * 8), g1 = *(const f32x4*)(lg + lane * 8 + 4), b0 = *(const f32x4*)(lb + lane * 8), b1 = *(const f32x4*)(lb + lane * 8 + 4);
#pragma unroll 1
      for (int t = 0; t < 4; ++t) { const int tl = wave * 4 + t;
          f32x4 x0 = *(const LAS f32x4*)(co + tl * 512 + lane * 8), x1 = *(const LAS f32x4*)(co + tl * 512 + lane * 8 + 4);
          const float mu = wave_sum((x0[0] + x0[1]) + (x0[2] + x0[3]) + (x1[0] + x1[1]) + (x1[2] + x1[3])) * (1.f / 512.f);
          x0 = x0 - mu; x1 = x1 - mu;
          const float var = wave_sum((x0[0] * x0[0] + x0[1] * x0[1]) + (x0[2] * x0[2] + x0[3] * x0[3]) + (x1[0] * x1[0] + x1[1] * x1[1]) + (x1[2] * x1[2] + x1[3] * x1[3])) * (1.f / 512.f);
          const float rs = rsqrtf(var + EPS);
          x0 = x0 * rs * g0 + b0; x1 = x1 * rs * g1 + b1;
#pragma unroll
          for (int e = 0; e < 4; ++e) { x0[e] = x0[e] * fsigmoid(x0[e]); x1[e] = x1[e] * fsigmoid(x1[e]); }
          *(v4u*)(CAT + (size_t)(row0 + tl) * 1024 + lane * 8) = pack8(x0, x1); } }
    __syncthreads();
}

__device__ __forceinline__ void rowwise_phase(int gw, int NGW, int lane, const float* xp, const float* xs, const bf16* br, const float* ngA, const float* gate,
                                              float* xout, const float* ngB, const float* mod2, int sc_off, int sh_off, bf16* H) {
    for (int row = gw; row < MT; row += NGW) {
        const int cond = row < MP ? 2 : (row - MP) >> 10;
        const float* xr = row < MP ? xp + (size_t)row * D : xs + (size_t)(row - MP) * D;
        f32x4 x[4];
#pragma unroll
        for (int j = 0; j < 4; ++j) x[j] = *(const f32x4*)(xr + lane * 4 + 256 * j);
        if (br) {
            f32x4 b[4]; float ss = 0.f;
#pragma unroll
            for (int j = 0; j < 4; ++j) { const v2u w = *(const v2u*)(br + (size_t)row * D + lane * 4 + 256 * j); b[j] = (f32x4){bflo(w.x), bfhi(w.x), bflo(w.y), bfhi(w.y)};
                ss += (b[j][0] * b[j][0] + b[j][1] * b[j][1]) + (b[j][2] * b[j][2] + b[j][3] * b[j][3]); }
            const float r = rsqrtf(wave_sum(ss) * (1.f / D) + EPS);
#pragma unroll
            for (int j = 0; j < 4; ++j) { const int col = lane * 4 + 256 * j; const f32x4 g = *(const f32x4*)(gate + cond * 6144 + col), na = *(const f32x4*)(ngA + col);
                x[j] = x[j] + g * (b[j] * r * na); *(f32x4*)(xout + (size_t)row * D + col) = x[j]; }
        }
        if (H) {
            float ss = 0.f;
#pragma unroll
            for (int j = 0; j < 4; ++j) ss += (x[j][0] * x[j][0] + x[j][1] * x[j][1]) + (x[j][2] * x[j][2] + x[j][3] * x[j][3]);
            const float r = rsqrtf(wave_sum(ss) * (1.f / D) + EPS);
#pragma unroll
            for (int j = 0; j < 4; ++j) { const int col = lane * 4 + 256 * j; const f32x4 nb = *(const f32x4*)(ngB + col), sc = *(const f32x4*)(mod2 + cond * 6144 + sc_off + col), sh = *(const f32x4*)(mod2 + cond * 6144 + sh_off + col);
                const f32x4 h = x[j] * r * nb * (sc + 1.f) + sh; v2u w; w.x = cvt_pk_bf16(h[0], h[1]); w.y = cvt_pk_bf16(h[2], h[3]); *(v2u*)(H + (size_t)row * D + col) = w; }
        }
    }
}

__device__ __forceinline__ void p0_transpose_item(const float* W, int K, int N, bf16* WT, int mode, LAS float* scr, int item, int lane) {
    const int nblk = N / 64, kb = item / nblk, nb = item % nblk, k0 = 64 * kb, n0 = 64 * nb;
    int d0 = n0;
    if (mode == 1) { if (n0 < 512) d0 = 256 * (n0 >> 7) + (n0 & 127); else if (n0 < 1024) { const int c = n0 - 512; d0 = 256 * (c >> 7) + 128 + (c & 127); } }
    else if (mode == 2) { if (n0 < FH) d0 = 256 * (n0 >> 7) + (n0 & 127); else { const int c = n0 - FH; d0 = 256 * (c >> 7) + 128 + (c & 127); } }
    f32x4 v[16];
    const float* src = W + (size_t)(k0 + (lane >> 4)) * N + n0 + 4 * (lane & 15);
#pragma unroll
    for (int i = 0; i < 16; ++i) v[i] = *(const f32x4*)(src + (size_t)(4 * i) * N);
#pragma unroll
    for (int i = 0; i < 16; ++i) { LAS float* d = scr + (4 * i + (lane >> 4)) * 65 + 4 * (lane & 15);
        d[0] = v[i][0]; d[1] = v[i][1]; d[2] = v[i][2]; d[3] = v[i][3]; }
    asm volatile("s_waitcnt lgkmcnt(0)" ::: "memory");
    const int c = lane & 7;
#pragma unroll
    for (int j = 0; j < 8; ++j) { const int n = (lane >> 3) + 8 * j; const LAS float* s = scr + (8 * c) * 65 + n;
        v4u o; o.x = pk2(s[0 * 65], s[1 * 65]); o.y = pk2(s[2 * 65], s[3 * 65]); o.z = pk2(s[4 * 65], s[5 * 65]); o.w = pk2(s[6 * 65], s[7 * 65]);
        *(v4u*)(WT + (size_t)(d0 + n) * K + k0 + 8 * c) = o; }
    asm volatile("s_waitcnt lgkmcnt(0)" ::: "memory");
}
__device__ __forceinline__ float fsilu(float x) { return x / (1.f + expf(-x)); }

__device__ __forceinline__ void gemv_item(const Args& a, LAS unsigned char* lds, int item, int tid) {
    const int layer = item / 96, n0 = (item % 96) * 64, lane = tid & 63, wave = tid >> 6;
    LAS float* sl = (LAS float*)lds;
    LAS float* part = (LAS float*)(lds + 12288);
    const float* c = a.in[6]; const float* cx = a.in[7];
    for (int i = tid; i < 3072; i += 512) { const float v = i < 2048 ? c[i] : cx[i - 2048]; sl[i] = v / (1.f + expf(-v)); }
    __syncthreads();
    const int cgp = lane & 15, rg = lane >> 4;
    const float* W = a.in[layer ? 21 : 8] + (size_t)(wave * 128 + rg) * 6144 + n0 + 4 * cgp;
    f32x4 a0 = {0.f, 0.f, 0.f, 0.f}, a1 = a0, a2 = a0;
#pragma unroll 16
    for (int i = 0; i < 32; ++i) { const f32x4 w = *(const f32x4*)(W + (size_t)(4 * i) * 6144); const int k = wave * 128 + 4 * i + rg; a0 = a0 + w * sl[k]; a1 = a1 + w * sl[1024 + k]; a2 = a2 + w * sl[2048 + k]; }
#pragma unroll
    for (int e = 0; e < 4; ++e) { a0[e] += __shfl_xor(a0[e], 16); a0[e] += __shfl_xor(a0[e], 32); a1[e] += __shfl_xor(a1[e], 16); a1[e] += __shfl_xor(a1[e], 32); a2[e] += __shfl_xor(a2[e], 16); a2[e] += __shfl_xor(a2[e], 32); }
    if (rg == 0) { *(LAS f32x4*)(part + (wave * 3 + 0) * 64 + 4 * cgp) = a0; *(LAS f32x4*)(part + (wave * 3 + 1) * 64 + 4 * cgp) = a1; *(LAS f32x4*)(part + (wave * 3 + 2) * 64 + 4 * cgp) = a2; }
    __syncthreads();
    if (tid < 192) { const int cond = tid >> 6, col = tid & 63; float s = a.in[layer ? 22 : 9][n0 + col];
#pragma unroll
        for (int w = 0; w < 8; ++w) s += part[(w * 3 + cond) * 64 + col];
        ((float*)(a.ws + WS_MOD))[(layer * 3 + cond) * 6144 + n0 + col] = s; }
    __syncthreads();
}

constexpr int I_WIN0 = 0, I_WOUT0 = 640, I_K0C = 896, I_K1C = 1408, I_V0C = 1920, I_V1C = 2176, I_RP = 2304, I_LAM = 2320, I_AEND = 2321;
constexpr int I_WGU0 = 2321, I_WDN0 = 3729, I_WQKV1 = 4433, I_WOUT1 = 4817, I_WGU1 = 5073, I_WDN1 = 6481, I_END = 7185;
__device__ __forceinline__ void prep_items(const Args& a, LAS unsigned char* lds, int lo, int hi, int w, int nw, int wave, int lane) {
    unsigned char* ws = a.ws;
    LAS float* scr = (LAS float*)(lds + wave * 16640);
    for (int it = lo + w; it < hi; it += nw) {
        if (it < I_WOUT0) p0_transpose_item(a.in[11], 1024, NIN0, (bf16*)(ws + WS_WIN0), 1, scr, it - I_WIN0, lane);
        else if (it < I_K0C) p0_transpose_item(a.in[18], 1024, 1024, (bf16*)(ws + WS_WOUT0), 0, scr, it - I_WOUT0, lane);
        else if (it < I_K1C) {
            const int r = it - I_K0C, b = r >> 8, t = r & 255; const float* s = a.in[2] + (size_t)r * 512 + lane * 8;
            const f32x4 v0 = *(const f32x4*)s, v1 = *(const f32x4*)(s + 4);
            *(v4u*)((bf16*)(ws + WS_K0) + (size_t)(MP + b * 1280 + 1024 + t) * 512 + lane * 8) = pack8(v0, v1);
        } else if (it < I_V0C) {
            const int r = it - I_K1C, b = r >> 8, t = r & 255; const f32x4 v0 = *(const f32x4*)(a.in[4] + (size_t)r * 256 + lane * 4);
            v2u w2; w2.x = cvt_pk_bf16(v0[0], v0[1]); w2.y = cvt_pk_bf16(v0[2], v0[3]);
            *(v2u*)((bf16*)(ws + WS_K1) + (size_t)(MP + b * 1280 + 1024 + t) * 256 + lane * 4) = w2;
        } else if (it < I_V1C) {
            const int r = it - I_V0C, dvb = r & 7, h = (r >> 3) & 3, tb = (r >> 5) & 3, b = r >> 7;
            const float* s = a.in[3] + ((size_t)(b * 256 + tb * 64 + lane) * 4 + h) * 128 + dvb * 16;
            bf16* d = (bf16*)(ws + WS_VT0S) + ((size_t)((b * 4 + h) * 128 + dvb * 16)) * 1280 + 1024 + tb * 64 + lane;
#pragma unroll
            for (int q = 0; q < 4; ++q) { const f32x4 v = *(const f32x4*)(s + 4 * q);
#pragma unroll
                for (int e = 0; e < 4; ++e) d[(size_t)(4 * q + e) * 1280] = (bf16)f2bf(v[e]); }
        } else if (it < I_RP) {
            const int r = it - I_V1C, db = r & 3, h = (r >> 2) & 3, tb = (r >> 4) & 3, b = r >> 6;
            const float* s = a.in[5] + ((size_t)(b * 256 + tb * 64 + lane) * 4 + h) * 64 + db * 16;
            bf16* d = (bf16*)(ws + WS_VT1S) + ((size_t)((b * 4 + h) * 64 + db * 16)) * 1280 + 1024 + tb * 64 + lane;
#pragma unroll
            for (int q = 0; q < 4; ++q) { const f32x4 v = *(const f32x4*)(s + 4 * q);
#pragma unroll
                for (int e = 0; e < 4; ++e) d[(size_t)(4 * q + e) * 1280] = (bf16)f2bf(v[e]); }
        } else if (it < I_LAM) {
            const int e = (it - I_RP) * 64 + lane, pos = e >> 4, i = e & 15;
            const float inv = 1.0f / powf(10000.0f, (float)(2 * i) / 32.0f), ang = (float)pos * inv;
            ((float*)(ws + WS_ROPEC))[e] = cosf(ang); ((float*)(ws + WS_ROPES))[e] = sinf(ang);
        } else if (it < I_AEND) {
            const float* lf = a.in[16];
            const float s1 = wave_sum(lf[lane] * lf[64 + lane]), s2 = wave_sum(lf[128 + lane] * lf[192 + lane]);
            if (lane == 0) *(float*)(ws + WS_LAM) = expf(s1) - expf(s2) + 0.2f;
        }
        else if (it < I_WDN0) p0_transpose_item(a.in[19], 1024, NGU, (bf16*)(ws + WS_WGU0), 2, scr, it - I_WGU0, lane);
        else if (it < I_WQKV1) p0_transpose_item(a.in[20], FH, 1024, (bf16*)(ws + WS_WDN0), 0, scr, it - I_WDN0, lane);
        else if (it < I_WOUT1) p0_transpose_item(a.in[24], 1024, NQKV1, (bf16*)(ws + WS_WQKV1), 0, scr, it - I_WQKV1, lane);
        else if (it < I_WGU1) p0_transpose_item(a.in[26], 1024, 1024, (bf16*)(ws + WS_WOUT1), 0, scr, it - I_WOUT1, lane);
        else if (it < I_WDN1) p0_transpose_item(a.in[27], 1024, NGU, (bf16*)(ws + WS_WGU1), 2, scr, it - I_WGU1, lane);
        else p0_transpose_item(a.in[28], FH, 1024, (bf16*)(ws + WS_WDN1), 0, scr, it - I_WDN1, lane);
    }
}

#define XB_TMO      128
#define XB_XCNT(j)  (256  + 64 * (j))
#define XB_XSUB(j)  (1280 + 64 * (j))
#define XB_XGEN(j)  (2304 + 64 * (j))
#define XB_TOP      3328
#define XB_TOPGEN   3392
#define XCD_BAR_WORDS 3456
#define XB_SPIN_CAP (1u << 18)

__device__ __forceinline__ unsigned xb_ld(unsigned* p)              { return __hip_atomic_load(p, __ATOMIC_RELAXED, __HIP_MEMORY_SCOPE_AGENT); }
__device__ __forceinline__ unsigned xb_add(unsigned* p, unsigned v) { return __hip_atomic_fetch_add(p, v, __ATOMIC_RELAXED, __HIP_MEMORY_SCOPE_AGENT); }
__device__ __forceinline__ unsigned xb_xcc_id() { return (unsigned)__builtin_amdgcn_s_getreg((3 << 11) | 20) & 0xFu; }
#define XB_SPIN(cond, bar) do { unsigned _sp = 0; while (cond) { __builtin_amdgcn_s_sleep(1); \
    if ((++_sp & 255u) == 0u) { if (xb_ld(&(bar)[XB_TMO])) break; if (_sp > XB_SPIN_CAP) { atomicAdd(&(bar)[XB_TMO], 1u); break; } } } } while (0)

struct XcdBarrier {
    unsigned* bar; unsigned x;
    volatile LAS unsigned* st;
};

__device__ __forceinline__ XcdBarrier xcd_barrier_post(unsigned* bar, volatile LAS unsigned* st) {
    XcdBarrier b; b.bar = bar; b.x = xb_xcc_id(); b.st = st;
    if (threadIdx.x == 0) (void)xb_add(&bar[XB_XCNT(b.x)], 1u);
    return b;
}
__device__ __forceinline__ void xcd_barrier_complete(unsigned* bar, unsigned x, unsigned& nloc, unsigned& nx) {
    const unsigned G = gridDim.x * gridDim.y * gridDim.z;
    unsigned sum, cnt, mine, sp = 0u;
    for (;;) {
        sum = 0u; cnt = 0u; mine = 0u;
#pragma unroll
        for (unsigned j = 0; j < 16; ++j) { const unsigned c = xb_ld(&bar[XB_XCNT(j)]); sum += c; cnt += (c > 0u) ? 1u : 0u; mine = (j == x) ? c : mine; }
        if (sum == G) break;
        __builtin_amdgcn_s_sleep(1);
        if ((++sp & 255u) == 0u) { if (xb_ld(&bar[XB_TMO])) break; if (sp > XB_SPIN_CAP) { atomicAdd(&bar[XB_TMO], 1u); break; } }
    }
    nloc = mine > 0u ? mine : 1u; nx = cnt > 0u ? cnt : 1u;
}

__device__ __forceinline__ void xcd_barrier(const XcdBarrier& b) {
    asm volatile("s_waitcnt vmcnt(0)" ::: "memory");
    __syncthreads();
    if (threadIdx.x == 0) {
        unsigned* bar = b.bar;
        __builtin_amdgcn_s_waitcnt(0);
        unsigned nloc = b.st[0], nx = b.st[1];
        if (nloc == 0u) { xcd_barrier_complete(bar, b.x, nloc, nx); b.st[0] = nloc; b.st[1] = nx; }
        const unsigned old = xb_add(&bar[XB_XSUB(b.x)], 1u);
        const unsigned gen = old / nloc;
        if (old + 1u == (gen + 1u) * nloc) {
            __builtin_amdgcn_fence(__ATOMIC_RELEASE, "agent");
            asm volatile("s_waitcnt vmcnt(0)" ::: "memory");
            const unsigned og = xb_add(&bar[XB_TOP], 1u);
            const unsigned tg = og / nx;
            if (og + 1u == (tg + 1u) * nx) xb_add(&bar[XB_TOPGEN], 1u);
            else XB_SPIN(xb_ld(&bar[XB_TOPGEN]) == tg, bar);
            __builtin_amdgcn_fence(__ATOMIC_ACQUIRE, "agent");
            xb_add(&bar[XB_XGEN(b.x)], 1u);
            asm volatile("s_waitcnt vmcnt(0)" ::: "memory");
        } else {
            XB_SPIN(xb_ld(&bar[XB_XGEN(b.x)]) == gen, bar);
            __builtin_amdgcn_fence(__ATOMIC_ACQUIRE, "agent");
            asm volatile("s_waitcnt vmcnt(0)" ::: "memory");
        }
    }
    __syncthreads();
}

__global__ void __launch_bounds__(512, 2) mega_fwd(Args a) {
    extern __shared__ __attribute__((aligned(16))) unsigned char lds_raw[];
    LAS unsigned char* lds = (LAS unsigned char*)lds_raw;
    cg::grid_group grid = cg::this_grid();
    const int tid = threadIdx.x, lane = tid & 63, wave = __builtin_amdgcn_readfirstlane(tid >> 6);
    const int G = gridDim.x, bx = blockIdx.x, gw = bx * 8 + wave, NGW = G * 8;
    unsigned char* ws = a.ws; float* out = a.out;
    const float* mod0 = (const float*)(ws + WS_MOD); const float* mod1 = mod0 + 3 * 6144;
    bf16* Hb = (bf16*)(ws + WS_H); bf16* CAT = (bf16*)(ws + WS_CAT); bf16* MIX = (bf16*)(ws + WS_MIX); bf16* ACT = (bf16*)(ws + WS_ACT);
    const float* rc = (const float*)(ws + WS_ROPEC); const float* rs = (const float*)(ws + WS_ROPES);
    float* Y = out + O_Y;
    const int lo = a.ph_lo, hi = a.ph_hi;
    volatile LAS unsigned* xst = (volatile LAS unsigned*)(lds + 140288);
    if (tid < 64) ((LAS unsigned*)(lds + 140288))[tid] = 0u;
    __syncthreads();
    XcdBarrier bar; bar.bar = (unsigned*)(ws + WS_BAR); bar.x = 0; bar.st = nullptr;
    if (hi - lo > 1) bar = xcd_barrier_post((unsigned*)(ws + WS_BAR), xst);
    if (lo == -12345) grid.sync();
#ifndef MK_NOCONV
#define MK_NOCONV 0
#endif
#ifndef MK_NOATT0
#define MK_NOATT0 0
#endif
#ifndef MK_PHMASK
#define MK_PHMASK 0xffffu
#endif
#define IN(k) (((MK_PHMASK >> (k)) & 1u) && lo <= (k) && (k) < hi)
#ifndef MK_XSYNC
#define MK_XSYNC 0
#endif
#ifndef MK_DUP
#define MK_DUP 0u
#endif
#define PH(k) if (IN(k)) for (int rep_ = 0; rep_ <= (int)((MK_DUP >> (k)) & 1u); ++rep_)
#define RSYNC do { if (rep_) xcd_barrier(bar); } while (0)
#define SEAM(k) do { if (IN(k) && IN((k) + 1)) xcd_barrier(bar); } while (0)
#define GEMM(EpiT, E, Ap, Bp, Nn, Kk) do { pg8::Gemm g{(const pg8::bf16_t*)(Ap), (const pg8::bf16_t*)(Bp), MT, (Nn), (Kk)}; pg8::StaticOrder S; S.init(MT, (Nn), G, bx); \
        pg8::gemm_phase<EpiT, pg8::StaticOrder, true, true>(lds, g, S, E); } while (0)

#ifndef MK_GPROBE
#define MK_GPROBE 0
#endif
    if (MK_GPROBE && G != 256 && hi - lo > 1) for (int q = 0; q < 40; ++q) xcd_barrier(bar);
    const bool ov = (G == 256);
    PH(0) { RSYNC; for (int j = bx; j < (ov ? 96 : 192); j += G) gemv_item(a, lds, j, tid); prep_items(a, lds, 0, ov ? I_AEND : I_END, gw, NGW, wave, lane); }
    SEAM(0);
    for (int xs_ = 0; xs_ < MK_XSYNC; ++xs_) xcd_barrier(bar);
    PH(1) { RSYNC; rowwise_phase(gw, NGW, lane, a.in[0], a.in[1], nullptr, nullptr, nullptr, nullptr, a.in[10], mod0, 1024, 0, Hb); }
    SEAM(1);
    PH(2) { RSYNC; EpiIn0 E{(bf16*)(ws + WS_Z), (bf16*)(ws + WS_Q0), (bf16*)(ws + WS_K0), (bf16*)(ws + WS_VT0P), (bf16*)(ws + WS_VT0S), out, rc, rs};
        GEMM(EpiIn0, E, Hb, ws + WS_WIN0, NIN0, 1024);
        if (ov && bx >= 144) prep_items(a, lds, I_WGU0, I_WDN0, (bx - 144) * 8 + wave, 112 * 8, wave, lane); }
    SEAM(2);
    PH(3) { RSYNC;
        const float lam = __hip_atomic_load((const float*)(ws + WS_LAM), __ATOMIC_RELAXED, __HIP_MEMORY_SCOPE_AGENT);
        const bf16* Q0 = (const bf16*)(ws + WS_Q0); const bf16* K0 = (const bf16*)(ws + WS_K0);
        const bool split = G >= 128;
        int u = bx, stride = G;
        if (split && bx >= 64) { u = 64 + (bx - 64); stride = G - 64; }
        for (; u < 640; u += stride) {
            if (u < 320 && !MK_NOATT0) { int row0, krow0, ldv, nt; const bf16* vt; int b, h;
                if (u < 64) { const int bh = u & 7, qb = u >> 3; b = bh >> 2; h = bh & 3; row0 = MP + b * 1024 + qb * 128; krow0 = MP + b * 1280; ldv = 1280; nt = 20; vt = (const bf16*)(ws + WS_VT0S); }
                else { const int p = u - 64, qb = p & 1, bh = p >> 1; b = bh >> 2; h = bh & 3; row0 = b * 256 + qb * 128; krow0 = b * 256; ldv = 256; nt = 4; vt = (const bf16*)(ws + WS_VT0P); }
                attn_unit<2, 128>(lds, tid, Q0 + (size_t)row0 * 512 + h * 128, 512, K0 + (size_t)krow0 * 512 + h * 128, 512,
                                  vt + (size_t)(b * 4 + h) * 128 * ldv, ldv, 0, nt, 0, 0, false, 0, lam, a.in[17], 0.f, CAT + (size_t)row0 * 1024 + 512 + h * 128, 1024);
                if (split && u < 64) break;
            } else if (!MK_NOCONV) conv_unit(lds, tid, u - 320, (const bf16*)(ws + WS_Z), a.in[12], a.in[13], a.in[14], a.in[15], CAT);
        }
    }
    SEAM(3);
    PH(4) { RSYNC; EpiStore E{MIX, 1024}; GEMM(EpiStore, E, CAT, ws + WS_WOUT0, 1024, 1024);
        if (ov && bx >= 160) prep_items(a, lds, I_WDN0, I_WQKV1, (bx - 160) * 8 + wave, 96 * 8, wave, lane); }
    SEAM(4);
    PH(5) { RSYNC; rowwise_phase(gw, NGW, lane, a.in[0], a.in[1], MIX, a.in[10] + 1024, mod0 + 2048, Y, a.in[10] + 2048, mod0, 4096, 3072, Hb); }
    SEAM(5);
    PH(6) { RSYNC; EpiSwiglu E{ACT}; GEMM(EpiSwiglu, E, Hb, ws + WS_WGU0, NGU, 1024); }
    SEAM(6);
    PH(7) { RSYNC; EpiStore E{MIX, 1024}; GEMM(EpiStore, E, ACT, ws + WS_WDN0, 1024, FH);
        if (ov && bx >= 160) { gemv_item(a, lds, 96 + (bx - 160), tid); prep_items(a, lds, I_WQKV1, I_END, (bx - 160) * 8 + wave, 96 * 8, wave, lane); } }
    SEAM(7);
    PH(8) { RSYNC; rowwise_phase(gw, NGW, lane, Y, Y + (size_t)MP * D, MIX, a.in[10] + 3072, mod0 + 5120, Y, a.in[23], mod1, 1024, 0, Hb); }
    SEAM(8);
    PH(9) { RSYNC; EpiQkv1 E{(bf16*)(ws + WS_Q1), (bf16*)(ws + WS_K1), (bf16*)(ws + WS_VT1P), (bf16*)(ws + WS_VT1S), out, rc, rs};
        GEMM(EpiQkv1, E, Hb, ws + WS_WQKV1, NQKV1, 1024); }
    SEAM(9);
    PH(10) { RSYNC;
        const bf16* Q1 = (const bf16*)(ws + WS_Q1); const bf16* K1 = (const bf16*)(ws + WS_K1);
        for (int u = bx; u < 1280; u += G) {
            int row0, krow0, ldv, b0, nb, qpos0, qh, bq; const bf16* vt; bool mk;
            if (u < 256) { const int qb = u >> 5, rest = u & 31; bq = rest >> 4; qh = rest & 15; row0 = MP + bq * 1024 + qb * 128; krow0 = MP + bq * 1280; ldv = 1280; vt = (const bf16*)(ws + WS_VT1S);
                const int wlo = (qb * 128 - 128) < 0 ? 0 : qb * 128 - 128, whi = (qb * 128 + 256) > 1024 ? 1024 : qb * 128 + 256; b0 = wlo; nb = (whi - wlo) / 64; qpos0 = qb * 128; mk = true; }
            else { const int p = u - 256, qb = p & 1, rest = p >> 1; qh = rest & 15; bq = rest >> 4; row0 = bq * 256 + qb * 128; krow0 = bq * 256; ldv = 256; vt = (const bf16*)(ws + WS_VT1P); b0 = 0; nb = 0; qpos0 = 0; mk = false; }
            const int hk = qh >> 2;
            attn_unit<1, 64>(lds, tid, Q1 + (size_t)row0 * 1024 + qh * 64, 1024, K1 + (size_t)krow0 * 256 + hk * 64, 256, vt + (size_t)(bq * 4 + hk) * 64 * ldv, ldv,
                             mk ? 1024 : 0, 4, b0, nb, mk, qpos0, 0.f, nullptr, a.in[25][qh], CAT + (size_t)row0 * 1024 + qh * 64, 1024);
        }
    }
    SEAM(10);
    PH(11) { RSYNC; EpiStore E{MIX, 1024}; GEMM(EpiStore, E, CAT, ws + WS_WOUT1, 1024, 1024); }
    SEAM(11);
    PH(12) { RSYNC; rowwise_phase(gw, NGW, lane, Y, Y + (size_t)MP * D, MIX, a.in[23] + 1024, mod1 + 2048, Y, a.in[23] + 2048, mod1, 4096, 3072, Hb); }
    SEAM(12);
    PH(13) { RSYNC; EpiSwiglu E{ACT}; GEMM(EpiSwiglu, E, Hb, ws + WS_WGU1, NGU, 1024); }
    SEAM(13);
    PH(14) { RSYNC; EpiStore E{MIX, 1024}; GEMM(EpiStore, E, ACT, ws + WS_WDN1, 1024, FH); }
    SEAM(14);
    PH(15) { RSYNC; rowwise_phase(gw, NGW, lane, Y, Y + (size_t)MP * D, MIX, a.in[23] + 3072, mod1 + 5120, Y, nullptr, nullptr, 0, 0, nullptr); }
#undef IN
#undef SEAM
#undef GEMM
}

extern "C" void kernel_launch(void* const* d_in, const int* in_sizes, int n_in, void* d_out, int out_size, void* d_ws, size_t ws_size, hipStream_t stream) {
    static int grid = 0;
    if (grid == 0) {
        if (n_in != 29 || ws_size < WS_END) { fprintf(stderr, "kernel_launch: unexpected n_in %d / ws %zu\n", n_in, ws_size); grid = -1; return; }
        int dev = 0, cus = 0, per_cu = 0;
        (void)hipGetDevice(&dev); (void)hipDeviceGetAttribute(&cus, hipDeviceAttributeMultiprocessorCount, dev);
        if (hipFuncSetAttribute((const void*)mega_fwd, hipFuncAttributeMaxDynamicSharedMemorySize, LDS_BYTES) != hipSuccess) { fprintf(stderr, "kernel_launch: hipFuncSetAttribute failed\n"); grid = -1; return; }
        if (hipOccupancyMaxActiveBlocksPerMultiprocessor(&per_cu, (const void*)mega_fwd, 512, LDS_BYTES) != hipSuccess || per_cu < 1) { fprintf(stderr, "kernel_launch: occupancy query says %d\n", per_cu); per_cu = 1; }
        (void)hipGetLastError();
        if (cus <= 0) cus = 256;
        grid = cus * (per_cu > 1 ? 1 : per_cu);
    }
    if (grid < 0) return;
    (void)hipMemsetAsync((char*)d_ws, 0, WS_ZERO_BYTES, stream);
    Args a{};
    for (int i = 0; i < 29; ++i) a.in[i] = (const float*)d_in[i];
    a.out = (float*)d_out; a.ws = (unsigned char*)d_ws;
#if MK_PER_PHASE
    for (int p = 0; p < NPH; ++p) { a.ph_lo = p; a.ph_hi = p + 1; hipLaunchKernelGGL(mega_fwd, dim3(grid), dim3(512), LDS_BYTES, stream, a); }
#else
    a.ph_lo = 0; a.ph_hi = NPH;
    void* args[] = {&a};
    hipError_t e = hipLaunchCooperativeKernel((const void*)mega_fwd, dim3(grid), dim3(512), args, LDS_BYTES, stream);
    if (e != hipSuccess) fprintf(stderr, "kernel_launch: cooperative launch failed: %s (grid %d)\n", hipGetErrorString(e), grid);
#endif
}
```
